# Optimizing an MI355X kernel written in HIP

```python
import jax, jax.numpy as jnp
from jax import lax
import numpy as np

D_MODEL = 2048
BATCH = 2
SEQ = 8192
DEPTH = 2

GRID_W = 64
HEAD_DIM = 128
N_Q_HEADS = 8
N_KV_HEADS = 2
ATTN_W = N_Q_HEADS * HEAD_DIM
KV_W = N_KV_HEADS * HEAD_DIM
CONV_W = D_MODEL // 4
CONV_K = 3
SGU_GROUPS = 4
SGU_GC = 128
SGU_W = SGU_GROUPS * SGU_GC
CHUNK = 128
Q_BLOCK = 128
MIX_W = ATTN_W + CONV_W + SGU_W
ROPE_THETA = 10000.0
AXIS_ROT = HEAD_DIM // 2
EPS = 1e-6
IN_SPLITS = (ATTN_W, KV_W, KV_W, ATTN_W,
             CONV_W, CONV_W, CONV_W, CONV_W,
             SGU_W, SGU_W, SGU_W)
IN_W = 2 * ATTN_W + 2 * KV_W + 4 * CONV_W + 3 * SGU_W

kernel_name = "hybrid_parallel_attn_conv_sgu_encoder"


def rms_norm(x, w):
    xf = x.astype(jnp.float32)
    y = xf * lax.rsqrt(jnp.mean(xf * xf, axis=-1, keepdims=True) + EPS)
    return (y * w.astype(jnp.float32)).astype(x.dtype)


def axial_rope_tables(seq_len):
    rows = seq_len // GRID_W
    row = jnp.repeat(jnp.arange(rows, dtype=jnp.float32), GRID_W)
    col = jnp.tile(jnp.arange(GRID_W, dtype=jnp.float32), rows)
    inv_freq = ROPE_THETA ** (-jnp.arange(0, AXIS_ROT, 2, dtype=jnp.float32) / AXIS_ROT)
    ang = jnp.stack([row, col], axis=-1)[:, :, None] * inv_freq
    ang = jnp.broadcast_to(ang[:, :, None, :], (seq_len, 2, 2, AXIS_ROT // 2)).reshape(seq_len, HEAD_DIM)
    return jnp.cos(ang), jnp.sin(ang)


def rotate_half_axial(x):
    xa = x.reshape(x.shape[:-1] + (2, 2, AXIS_ROT // 2))
    rot = jnp.stack([-xa[..., 1, :], xa[..., 0, :]], axis=-2)
    return rot.reshape(x.shape)


def attention_branch(q, k, v, q_norm_w, k_norm_w, cos, sin):
    B, S, _ = q.shape
    g = N_Q_HEADS // N_KV_HEADS
    q = rms_norm(q.reshape(B, S, N_Q_HEADS, HEAD_DIM), q_norm_w).astype(jnp.float32)
    k = rms_norm(k.reshape(B, S, N_KV_HEADS, HEAD_DIM), k_norm_w).astype(jnp.float32)
    v = v.reshape(B, S, N_KV_HEADS, HEAD_DIM)
    c, s_ = cos[None, :, None, :], sin[None, :, None, :]
    q = q * c + rotate_half_axial(q) * s_
    k = k * c + rotate_half_axial(k) * s_
    n_blk = S // Q_BLOCK
    qb = q.reshape(B, n_blk, Q_BLOCK, N_KV_HEADS, g, HEAD_DIM).transpose(1, 0, 2, 3, 4, 5)
    scale = HEAD_DIM ** -0.5

    def attend(q_blk):
        scores = jnp.einsum('bqkgd,bskd->bkgqs', q_blk, k) * scale
        p = jax.nn.softmax(scores, axis=-1)
        return jnp.einsum('bkgqs,bskd->bqkgd', p.astype(v.dtype), v)

    o = lax.map(attend, qb)
    return o.transpose(1, 0, 2, 3, 4, 5).reshape(B, S, ATTN_W)


def short_conv_branch(c_in, c_b, c_c, conv_w):
    h = c_c * c_in
    hp = jnp.pad(h, ((0, 0), (1, 1), (0, 0)))
    y = hp[:, :-2] * conv_w[:, 0] + hp[:, 1:-1] * conv_w[:, 1] + hp[:, 2:] * conv_w[:, 2]
    return c_b * y


def sgu_branch(u, v, sgu_norm_w, sgu_w, sgu_b):
    B, S, _ = u.shape
    u = jax.nn.gelu(u, approximate=False)
    v = jax.nn.gelu(v, approximate=False)
    v = rms_norm(v.reshape(B, S, SGU_GROUPS, SGU_GC), sgu_norm_w.reshape(SGU_GROUPS, SGU_GC))
    vc = v.reshape(B, S // CHUNK, CHUNK, SGU_GROUPS, SGU_GC)
    s = jnp.einsum('gpq,bnqgc->bnpgc', sgu_w, vc) + sgu_b.T[:, :, None]
    return u * s.reshape(B, S, SGU_W)


def hybrid_layer(x, cos, sin, norm_w, w_in, q_norm_w, k_norm_w, conv_w, sgu_norm_w, sgu_w, sgu_b,
                 branch_norm_w, w_out):
    h = rms_norm(x, norm_w)
    proj = jnp.einsum('bsd,de->bse', h, w_in)
    cuts, acc = [], 0
    for width in IN_SPLITS[:-1]:
        acc += width
        cuts.append(acc)
    (q, k, v, g_attn, c_in, c_b, c_c, g_conv, s_u, s_v, g_sgu) = jnp.split(proj, cuts, axis=-1)

    o_attn = attention_branch(q, k, v, q_norm_w, k_norm_w, cos, sin)
    o_conv = short_conv_branch(c_in, c_b, c_c, conv_w)
    o_sgu = sgu_branch(s_u, s_v, sgu_norm_w, sgu_w, sgu_b)

    o_attn = rms_norm(o_attn, branch_norm_w[:ATTN_W]) * jax.nn.silu(g_attn)
    o_conv = rms_norm(o_conv, branch_norm_w[ATTN_W:ATTN_W + CONV_W]) * jax.nn.silu(g_conv)
    o_sgu = rms_norm(o_sgu, branch_norm_w[ATTN_W + CONV_W:]) * jax.nn.silu(g_sgu)
    mixed = jnp.concatenate([o_attn, o_conv, o_sgu], axis=-1)
    return x + jnp.einsum('bse,ed->bsd', mixed, w_out)


def setup_inputs(seed: int = 0) -> dict:
    key = jax.random.key(seed)
    ks = jax.random.split(key, 12)

    def nrm(k, shape, scale):
        return jax.random.normal(k, shape, jnp.float32) * scale

    return {
        "x": nrm(ks[0], (BATCH, SEQ, D_MODEL), 1.0),
        "norm_w": 1.0 + nrm(ks[1], (DEPTH, D_MODEL), 0.02),
        "w_in": nrm(ks[2], (DEPTH, D_MODEL, IN_W), D_MODEL ** -0.5),
        "q_norm_w": 1.0 + nrm(ks[3], (DEPTH, HEAD_DIM), 0.02),
        "k_norm_w": 1.0 + nrm(ks[4], (DEPTH, HEAD_DIM), 0.02),
        "conv_w": nrm(ks[5], (DEPTH, CONV_W, CONV_K), CONV_K ** -0.5),
        "sgu_norm_w": 1.0 + nrm(ks[6], (DEPTH, SGU_W), 0.02),
        "sgu_w": nrm(ks[7], (DEPTH, SGU_GROUPS, CHUNK, CHUNK), CHUNK ** -0.5),
        "sgu_b": 1.0 + nrm(ks[8], (DEPTH, SGU_GROUPS, CHUNK), 0.01),
        "branch_norm_w": 1.0 + nrm(ks[9], (DEPTH, MIX_W), 0.02),
        "w_out": nrm(ks[10], (DEPTH, MIX_W, D_MODEL), MIX_W ** -0.5),
        "final_norm_w": 1.0 + nrm(ks[11], (D_MODEL,), 0.02),
    }


def reference(x, norm_w, w_in, q_norm_w, k_norm_w, conv_w, sgu_norm_w, sgu_w, sgu_b,
              branch_norm_w, w_out, final_norm_w):
    cos, sin = axial_rope_tables(x.shape[1])
    for layer in range(DEPTH):
        x = hybrid_layer(x, cos, sin, norm_w[layer], w_in[layer], q_norm_w[layer], k_norm_w[layer],
                         conv_w[layer], sgu_norm_w[layer], sgu_w[layer], sgu_b[layer],
                         branch_norm_w[layer], w_out[layer])
    return rms_norm(x, final_norm_w)
```

```cpp
#include <hip/hip_runtime.h>
#include <hip/hip_bf16.h>
#include <cstdio>
#include <cstdint>
#include <cmath>
constexpr int BATCH = 2, SEQ = 8192, DM = 2048, DEPTH = 2, M = BATCH * SEQ;
constexpr int HD = 128, NQH = 8, NKVH = 2, ATTN_W = 1024, KV_W = 256, CONV_W = 512, SGU_W = 512, SGU_G = 4, CHUNK = 128, IN_W = 6144, MIX_W = 2048;
constexpr int C_Q = 0, C_K = 1024, C_V = 1280, C_GA = 1536, C_CIN = 2560, C_CB = 3072, C_CC = 3584, C_GC = 4096, C_SU = 4608, C_SV = 5120, C_GS = 5632;
constexpr float EPS = 1e-6f;
constexpr int NWAVES = 8, LDS_BYTES = 147456;
constexpr int RING_BYTES = 131072, XCH_OFF = RING_BYTES, MISC_OFF = RING_BYTES + 8192;
constexpr int CW_BAR = 4096; constexpr size_t CTL_ZERO_BYTES = 65536;
constexpr size_t MiB = 1u << 20;
#ifndef PADK
#define PADK 0
#endif
constexpr int LDK2 = DM + PADK;
constexpr size_t WS_CTL = 0, WS_TAB = 1 * MiB, WS_WSB = 1 * MiB + 64 * 1024, WS_SSQP = 1 * MiB + 512 * 1024, WS_WIN = 2 * MiB, WS_WOUT = 52 * MiB, WS_XB = 70 * MiB, WS_Q = 136 * MiB, WS_K = 168 * MiB, WS_V = 176 * MiB,
                 WS_MIX = 184 * MiB, WS_H = 250 * MiB, WS_CB = 266 * MiB, WS_U = 282 * MiB, WS_VN = 298 * MiB, WS_SSQA = 314 * MiB, WS_END = 315 * MiB;
static_assert(WS_WIN + (size_t)DEPTH * IN_W * LDK2 * 2 <= WS_WOUT && WS_WOUT + (size_t)DEPTH * DM * LDK2 * 2 <= WS_XB && WS_XB + (size_t)M * LDK2 * 2 <= WS_Q && WS_Q + (size_t)M * ATTN_W * 2 <= WS_K && WS_K + (size_t)M * KV_W * 2 <= WS_V
              && WS_V + (size_t)M * KV_W * 2 <= WS_MIX && WS_MIX + (size_t)M * LDK2 * 2 <= WS_H && WS_H + (size_t)M * CONV_W * 2 <= WS_CB && WS_CB + (size_t)M * CONV_W * 2 <= WS_U && WS_U + (size_t)M * SGU_W * 2 <= WS_VN
              && WS_VN + (size_t)M * SGU_W * 2 <= WS_SSQA && WS_SSQA + (size_t)M * 8 * 4 <= WS_END && WS_SSQP + (size_t)M * 8 * 4 <= WS_WIN && WS_TAB + 128 * 32 * 8 <= WS_WSB && WS_WSB + (size_t)DEPTH * SGU_G * CHUNK * CHUNK * 2 <= WS_SSQP, "d_ws map");
#define ATT_LDQ 1024
#define ATT_LDK 256
#define ATT_LDO 1024
#define ATT_LDG LDK2
__device__ __forceinline__ int ltid() { int t = threadIdx.x; asm volatile("" : "+v"(t)); return t; }
namespace pg8 {
#define PG8_LAS __attribute__((address_space(3)))
typedef unsigned short bf16_t;
typedef short bf16x8 __attribute__((ext_vector_type(8)));
typedef float f32x4 __attribute__((ext_vector_type(4)));
typedef unsigned u32x4 __attribute__((ext_vector_type(4)));
constexpr int BM = 256, BK = 64, HALF = 128, HTB = HALF * BK * 2  , STAGE_BYTES = 8 * HTB, NXCD = 8, WGM = 8;

__host__ __device__ __forceinline__ int lds_byte(int r, int c) { const int st = (r >> 4) * 2 + (c >> 5), rr = r & 15, cc = c & 31, ob = rr * 64 + cc * 2; return st * 1024 + (ob ^ (((ob >> 9) & 1) << 5)); }
__host__ __device__ __forceinline__ void stage_rc(int b, int& R, int& C) { const int st = b / 1024, sb = b % 1024, swz = sb ^ (((sb >> 9) & 1) << 5); R = (st >> 1) * 16 + swz / 64; C = (st & 1) * 32 + (swz % 64) / 2; }
__host__ __device__ __forceinline__ int perm32(int rho) { const int n = rho >> 4, i = rho & 15; return 8 * (i >> 2) + 4 * n + (i & 3); }

struct Unit { int pm, pn; };
struct Gemm { const bf16_t* A; const bf16_t* Bt; int M, N, K, ld; };

struct StaticOrder {
    int nM, nN, nwg, G, c;
    __host__ __device__ void init(int M, int N, int G_, int c_) { nM = M / BM; nN = N / BM; nwg = nM * nN; G = G_; c = c_; }
    __host__ __device__ bool next(int i, Unit& u) const {
        const long L = (long)i * G + c; if (L >= nwg) return false;
        int wgid = (int)L; { const int q = nwg / NXCD, r = nwg % NXCD, xcd = wgid % NXCD, off = wgid / NXCD; wgid = (xcd < r ? xcd * (q + 1) : r * (q + 1) + (xcd - r) * q) + off; }
        const int nig = WGM * nN, gid = wgid / nig, fm = gid * WGM, gsz = (nM - fm) < WGM ? (nM - fm) : WGM;
        u.pm = fm + ((wgid % nig) % gsz); u.pn = (wgid % nig) / gsz; return true;
    }
    __device__ __forceinline__ void a_ready(const Unit&) const {}
    __device__ __forceinline__ void done(const Unit&) const {}
};

__device__ __forceinline__ unsigned cvt_pk_bf16(float lo, float hi) { unsigned r; asm volatile("v_cvt_pk_bf16_f32 %0, %1, %2" : "=v"(r) : "v"(lo), "v"(hi)); return r; }
typedef float f32x2 __attribute__((ext_vector_type(2)));
__device__ __forceinline__ f32x2 gelu_pk(f32x2 v) {
    const f32x2 av = __builtin_elementwise_abs(v), d = av * 0.2316418882f + 1.0f;
    f32x2 t; t.x = __builtin_amdgcn_rcpf(d.x); t.y = __builtin_amdgcn_rcpf(d.y);
    f32x2 q = t * 0.5307027145f + (-0.7265760135f); q = q * t + 0.7107068705f; q = q * t + (-0.142248368f); q = q * t + 0.127414796f; q = q * t;
    const f32x2 s = (v * v) * (-0.72134752044f);
    f32x2 e; e.x = __builtin_amdgcn_exp2f(s.x); e.y = __builtin_amdgcn_exp2f(s.y);
    const f32x2 m = v * (q * e), r = v - m;
    f32x2 o; o.x = v.x < 0.f ? m.x : r.x; o.y = v.y < 0.f ? m.y : r.y; return o;
}

template <int ACT  > struct EpiBf16 {
    static constexpr bool PERM = true, AFTER_DRAIN = false; static_assert(ACT == 0 || ACT == 1, "EpiBf16: ACT is 0 (none) or 1 (gelu_pk)");
    bf16_t* O; int ldc; const float* bias; int split_cols; size_t split_stride; float scale0;
    __device__ __forceinline__ void operator()(const f32x4 (&acc)[2][2][4][2], const Unit& u, int wr, int wc, int fr, int fq) const {
        const int row0 = u.pm * BM + wr * 64 + fr; int colt = u.pn * BM; bf16_t* base = O;
        float sc = 1.f; if (split_cols) { const int t = colt / split_cols; base += (size_t)t * split_stride; colt -= t * split_cols; if (t == 0) sc = scale0; }
        const int col0 = colt + wc * 32 + 8 * fq, bcol0 = u.pn * BM + wc * 32 + 8 * fq;
        f32x4 bv[2][2];
#pragma unroll
        for (int bj = 0; bj < 2; ++bj)
#pragma unroll
            for (int n = 0; n < 2; ++n) bv[bj][n] = bias ? *(const f32x4*)(bias + bcol0 + bj * HALF + 4 * n) : (f32x4){0.f, 0.f, 0.f, 0.f};
#pragma unroll
        for (int ai = 0; ai < 2; ++ai)
#pragma unroll
            for (int m = 0; m < 4; ++m) { bf16_t* rowp = base + (size_t)(row0 + ai * HALF + m * 16) * ldc + col0;
#pragma unroll
                for (int bj = 0; bj < 2; ++bj) { f32x4 v0 = acc[ai][bj][m][0] + bv[bj][0], v1 = acc[ai][bj][m][1] + bv[bj][1];
                    if (ACT == 1) { f32x2 a = gelu_pk((f32x2){v0[0], v0[1]}), b = gelu_pk((f32x2){v0[2], v0[3]}), c = gelu_pk((f32x2){v1[0], v1[1]}), d = gelu_pk((f32x2){v1[2], v1[3]});
                        v0 = (f32x4){a.x, a.y, b.x, b.y}; v1 = (f32x4){c.x, c.y, d.x, d.y}; }
                    v0 = v0 * sc; v1 = v1 * sc; u32x4 w; w.x = cvt_pk_bf16(v0[0], v0[1]); w.y = cvt_pk_bf16(v0[2], v0[3]); w.z = cvt_pk_bf16(v1[0], v1[1]); w.w = cvt_pk_bf16(v1[2], v1[3]);
                    *(u32x4*)(rowp + bj * HALF) = w; } }
    }
};
template <class Epi, class Sched, bool ALIGN_EPI = false, bool SP2 = false>
__device__ __forceinline__ void gemm_phase(PG8_LAS unsigned char* lds, const Gemm g, const Sched& S, const Epi& E) {
    const int tid = ltid(), wid = __builtin_amdgcn_readfirstlane(tid >> 6), lane = tid & 63, wr = wid >> 2, wc = wid & 3, fr = lane & 15, fq = lane >> 4;
    const int K = g.K, nt = K / BK, LD = g.ld;
    unsigned voffA[2], voffB[2];
#pragma unroll
    for (int i = 0; i < 2; ++i) { int R, C; stage_rc(tid * 16 + i * 8192, R, C); const int Rb = Epi::PERM ? ((R & ~31) + perm32(R & 31)) : R;
        voffA[i] = (unsigned)(R * LD + C) * 2u; voffB[i] = (unsigned)(Rb * LD + C) * 2u; }
    const size_t kstep = (size_t)(BK * 2);
    const size_t hstep = (size_t)HALF * LD * 2;
    const size_t tstep = 2 * hstep;
    const unsigned ldsw = (unsigned)wid * 1024u;
    const int aoff = lds_byte(wr * 64 + fr, fq * 8), boff = lds_byte(wc * 32 + fr, fq * 8);
#define PG8_SA(b, h) (((b) * 2 + (h)) * HTB)
#define PG8_SB(b, h) ((4 + (b) * 2 + (h)) * HTB)
#define PG8_STAGE(bufoff, gbase, voff) do { _Pragma("unroll") for (int _i = 0; _i < 2; ++_i) \
        __builtin_amdgcn_global_load_lds((const unsigned*)((const char*)(gbase) + (voff)[_i]), (PG8_LAS unsigned*)(lds + (bufoff) + ldsw + _i * 8192), 16, 0, 0); } while (0)
#define PG8_LDA(dst, b, h) do { _Pragma("unroll") for (int m = 0; m < 4; ++m) _Pragma("unroll") for (int k = 0; k < 2; ++k) dst[m][k] = *(const PG8_LAS bf16x8*)(lds + PG8_SA(b, h) + aoff + m * 2048 + k * 1024); } while (0)
#define PG8_LDB(dst, b, h) do { _Pragma("unroll") for (int n = 0; n < 2; ++n) _Pragma("unroll") for (int k = 0; k < 2; ++k) dst[n][k] = *(const PG8_LAS bf16x8*)(lds + PG8_SB(b, h) + boff + n * 2048 + k * 1024); } while (0)
#define PG8_MMA(ai, bj, At, Bt) do { __builtin_amdgcn_s_setprio(1); _Pragma("unroll") for (int m = 0; m < 4; ++m) _Pragma("unroll") for (int n = 0; n < 2; ++n) _Pragma("unroll") for (int k = 0; k < 2; ++k) \
        acc[ai][bj][m][n] = __builtin_amdgcn_mfma_f32_16x16x32_bf16(Bt[n][k], At[m][k], acc[ai][bj][m][n], 0, 0, 0); __builtin_amdgcn_s_setprio(0); } while (0)
#define PG8_WAIT_V(n) asm volatile("s_waitcnt vmcnt(" #n ")" ::: "memory")
#define PG8_WAIT_L(n) asm volatile("s_waitcnt lgkmcnt(" #n ")" ::: "memory")
#define PG8_BAR __builtin_amdgcn_s_barrier()
#define PG8_SCHED __builtin_amdgcn_sched_barrier(0)
    Unit cur, nxt; int ui = 0;
    if (!S.next(0, cur)) return;
    f32x4 acc[2][2][4][2];
#pragma unroll
    for (int a = 0; a < 2; ++a)
#pragma unroll
        for (int b = 0; b < 2; ++b)
#pragma unroll
            for (int m = 0; m < 4; ++m)
#pragma unroll
                for (int n = 0; n < 2; ++n) acc[a][b][m][n] = (f32x4){0.f, 0.f, 0.f, 0.f};
    bf16x8 At[4][2], B0[2][2], B1[2][2];
    const char* cA = (const char*)g.A + (size_t)cur.pm * tstep; const char* cB = (const char*)g.Bt + (size_t)cur.pn * tstep;
    S.a_ready(cur);
    if constexpr (SP2) {
        PG8_STAGE(PG8_SB(0, 0), cB, voffB); PG8_STAGE(PG8_SB(0, 1), cB + hstep, voffB); PG8_STAGE(PG8_SA(0, 0), cA, voffA); PG8_STAGE(PG8_SA(0, 1), cA + hstep, voffA);
        E.prep(cur, wr, wc, fr, fq);
        if (wr == 1) PG8_BAR;
        PG8_WAIT_V(2); PG8_BAR;
        PG8_STAGE(PG8_SB(1, 0), cB + kstep, voffB); PG8_STAGE(PG8_SA(1, 0), cA + kstep, voffA); PG8_STAGE(PG8_SB(1, 1), cB + hstep + kstep, voffB);
        PG8_WAIT_V(6); PG8_BAR;
    } else {
        PG8_STAGE(PG8_SB(0, 0), cB, voffB); PG8_STAGE(PG8_SA(0, 0), cA, voffA); PG8_STAGE(PG8_SB(0, 1), cB + hstep, voffB); PG8_STAGE(PG8_SA(0, 1), cA + hstep, voffA);
        if (wr == 1) PG8_BAR;
        PG8_WAIT_V(4); PG8_BAR;
        PG8_STAGE(PG8_SB(1, 0), cB + kstep, voffB); PG8_STAGE(PG8_SA(1, 0), cA + kstep, voffA); PG8_STAGE(PG8_SB(1, 1), cB + hstep + kstep, voffB);
        PG8_WAIT_V(6); PG8_BAR;
    }
    for (;;) {
        const bool has_next = S.next(ui + 1, nxt);
        const char* nA = has_next ? (const char*)g.A + (size_t)nxt.pm * tstep : cA; const char* nB = has_next ? (const char*)g.Bt + (size_t)nxt.pn * tstep : cB;
        for (int t = 0; t < nt; t += 2) {
            if constexpr (Epi::MIDK > 0) { if (t == Epi::MIDK) E.midk(acc, cur, wr, wc, fr, fq); }
            const bool last = (t == nt - 2);
            const char* a1 = cA + (size_t)(t + 1) * kstep;
            const char* a2 = last ? nA : cA + (size_t)(t + 2) * kstep; const char* b2 = last ? nB : cB + (size_t)(t + 2) * kstep;
            const char* a3 = a2 + kstep; const char* b3 = b2 + kstep;
            if (last && has_next) S.a_ready(nxt);
            if constexpr (SP2) {
            PG8_LDB(B0, 0, 0); PG8_LDB(B1, 0, 1); PG8_SCHED; PG8_LDA(At, 0, 0); PG8_STAGE(PG8_SA(1, 1), a1 + hstep, voffA);
            PG8_WAIT_V(8); PG8_WAIT_L(0); PG8_BAR; PG8_MMA(0, 0, At, B0); PG8_MMA(0, 1, At, B1); PG8_BAR; PG8_SCHED;
            PG8_LDA(At, 0, 1); PG8_STAGE(PG8_SB(0, 0), b2, voffB); PG8_STAGE(PG8_SB(0, 1), b2 + hstep, voffB); PG8_STAGE(PG8_SA(0, 0), a2, voffA);
            PG8_WAIT_V(8); PG8_WAIT_L(0); PG8_BAR; PG8_MMA(1, 0, At, B0); PG8_MMA(1, 1, At, B1); PG8_BAR; PG8_SCHED;
            PG8_LDB(B0, 1, 0); PG8_LDB(B1, 1, 1); PG8_SCHED; PG8_LDA(At, 1, 0); PG8_STAGE(PG8_SA(0, 1), a2 + hstep, voffA);
            PG8_WAIT_V(8); PG8_WAIT_L(0); PG8_BAR; PG8_MMA(0, 0, At, B0); PG8_MMA(0, 1, At, B1); PG8_BAR; PG8_SCHED;
            PG8_LDA(At, 1, 1); PG8_STAGE(PG8_SB(1, 0), b3, voffB); PG8_STAGE(PG8_SB(1, 1), b3 + hstep, voffB); PG8_STAGE(PG8_SA(1, 0), a3, voffA);
            PG8_WAIT_V(8); PG8_WAIT_L(0); PG8_BAR; PG8_MMA(1, 0, At, B0); PG8_MMA(1, 1, At, B1); PG8_BAR; PG8_SCHED;
            } else {
            PG8_LDB(B0, 0, 0); PG8_SCHED; PG8_LDA(At, 0, 0); PG8_STAGE(PG8_SA(1, 1), a1 + hstep, voffA);
            PG8_WAIT_L(8); PG8_BAR; PG8_WAIT_L(0); PG8_MMA(0, 0, At, B0); PG8_BAR; PG8_SCHED;
            PG8_LDB(B1, 0, 1); PG8_STAGE(PG8_SB(0, 0), b2, voffB);
            PG8_BAR; PG8_WAIT_L(0); PG8_MMA(0, 1, At, B1); PG8_BAR;
            PG8_LDA(At, 0, 1); PG8_STAGE(PG8_SA(0, 0), a2, voffA);
            PG8_BAR; PG8_WAIT_L(0); PG8_MMA(1, 0, At, B0); PG8_BAR; PG8_SCHED;
            PG8_STAGE(PG8_SB(0, 1), b2 + hstep, voffB);
            PG8_WAIT_V(6); PG8_BAR; PG8_MMA(1, 1, At, B1); PG8_BAR;
            PG8_LDB(B0, 1, 0); PG8_SCHED; PG8_LDA(At, 1, 0); PG8_STAGE(PG8_SA(0, 1), a2 + hstep, voffA);
            PG8_WAIT_L(8); PG8_BAR; PG8_WAIT_L(0); PG8_MMA(0, 0, At, B0); PG8_BAR; PG8_SCHED;
            PG8_LDB(B1, 1, 1); PG8_STAGE(PG8_SB(1, 0), b3, voffB);
            PG8_BAR; PG8_WAIT_L(0); PG8_MMA(0, 1, At, B1); PG8_BAR;
            PG8_LDA(At, 1, 1); PG8_STAGE(PG8_SA(1, 0), a3, voffA);
            PG8_BAR; PG8_WAIT_L(0); PG8_MMA(1, 0, At, B0); PG8_BAR; PG8_SCHED;
            PG8_STAGE(PG8_SB(1, 1), b3 + hstep, voffB);
            PG8_WAIT_V(6); PG8_BAR; PG8_MMA(1, 1, At, B1); PG8_BAR;
            }
        }
        if constexpr (ALIGN_EPI) { if (wr == 0) PG8_BAR; }
        if constexpr (!Epi::AFTER_DRAIN) { E(acc, cur, wr, wc, fr, fq); S.done(cur); }
        if (!has_next) break;
        E.prep(nxt, wr, wc, fr, fq);
#pragma unroll
        for (int a = 0; a < 2; ++a)
#pragma unroll
            for (int b = 0; b < 2; ++b)
#pragma unroll
                for (int m = 0; m < 4; ++m)
#pragma unroll
                    for (int n = 0; n < 2; ++n) acc[a][b][m][n] = (f32x4){0.f, 0.f, 0.f, 0.f};
        cur = nxt; cA = nA; cB = nB; ++ui;
        if constexpr (ALIGN_EPI) { if (wr == 1) PG8_BAR; }
    }
    PG8_WAIT_V(0);
    if constexpr (!ALIGN_EPI) { if (wr == 0) PG8_BAR; }
    PG8_BAR;
    if constexpr (Epi::AFTER_DRAIN) { E.fused(acc, cur, wr, wc, fr, fq, lds, wid, lane); S.done(cur); }
#undef PG8_SA
#undef PG8_SB
#undef PG8_STAGE
#undef PG8_LDA
#undef PG8_LDB
#undef PG8_MMA
#undef PG8_WAIT_V
#undef PG8_WAIT_L
#undef PG8_BAR
#undef PG8_SCHED
}
}

namespace att {
using bf16 = __hip_bfloat16;
constexpr int   D = 128, NW = 8, QBLK = 32, KVBLK = 64;
constexpr float SCALE = 0.088388347648318440f;
constexpr float THR = 8.f;
constexpr int SDEPTH = 1;
constexpr int LDQ = ATT_LDQ, LDK = ATT_LDK, LDO = ATT_LDO, LDG = ATT_LDG;
constexpr size_t SHM_V = KVBLK * D * 2, SHM_K = KVBLK * D * 2, SHM_ATTN = 2 * SHM_V + 2 * SHM_K + NW * 64 * 4;
using bf16x8 = __attribute__((ext_vector_type(8))) short;
using s16x4  = __attribute__((ext_vector_type(4))) short;
using f32x16 = __attribute__((ext_vector_type(16))) float;
using f32x8  = __attribute__((ext_vector_type(8))) float;
using u32x4  = __attribute__((ext_vector_type(4))) unsigned;
#define KSWZ(row, colB) ((row) * 256 + ((colB) ^ (((row) & 7) << 4)))
#define SBAR() __builtin_amdgcn_sched_barrier(0)
__device__ __forceinline__ int crow(int r, int hi) { return (r & 3) + 8 * (r >> 2) + 4 * hi; }
__device__ __forceinline__ unsigned cvtpk(float lo, float hi) {
  unsigned r; asm volatile("v_cvt_pk_bf16_f32 %0, %1, %2" : "=v"(r) : "v"(lo), "v"(hi)); return r;
}
template <typename TIn> struct Stage;
template <> struct Stage<bf16>  { using T = bf16x8;
  __device__ static __forceinline__ T ld8(const bf16* p) { return *reinterpret_cast<const bf16x8*>(p); }
  __device__ static __forceinline__ bf16x8 tobf(T x) { return x; } };
template <> struct Stage<float> { using T = f32x8;
  __device__ static __forceinline__ T ld8(const float* p) { return *reinterpret_cast<const f32x8*>(p); }
  __device__ static __forceinline__ bf16x8 tobf(T x) {
    u32x4 w = {cvtpk(x[0], x[1]), cvtpk(x[2], x[3]), cvtpk(x[4], x[5]), cvtpk(x[6], x[7])}; return *reinterpret_cast<bf16x8*>(&w); } };

__device__ __forceinline__ void partialSM(f32x16& p0, f32x16& p1, float& m_reg, float& mn, float& alpha) {
  constexpr float C = SCALE * 1.4426950408889634f;
  float pmax = p0[0]; for (int r = 1; r < 16; ++r) pmax = fmaxf(pmax, p0[r]); for (int r = 0; r < 16; ++r) pmax = fmaxf(pmax, p1[r]);
  { auto rr = __builtin_amdgcn_permlane32_swap(__float_as_uint(pmax), __float_as_uint(pmax), false, false);
    pmax = fmaxf(__uint_as_float(rr[0]), __uint_as_float(rr[1])); }
  if (__builtin_expect(__all(pmax - m_reg <= THR / SCALE), 1)) { mn = m_reg; alpha = 1.f; }
  else { mn = fmaxf(m_reg, pmax); alpha = __builtin_amdgcn_exp2f((m_reg - mn) * C); m_reg = mn; }
  float mnC = -mn * C;
  for (int r = 0; r < 16; ++r) p0[r] = fmaf(p0[r], C, mnC); for (int r = 0; r < 16; ++r) p1[r] = fmaf(p1[r], C, mnC);
  for (int r = 0; r < 16; ++r) p0[r] = __builtin_amdgcn_exp2f(p0[r]);
}
__device__ __forceinline__ void finishSM(f32x16& p0, f32x16& p1, float alpha, float& l_reg, bf16x8& pa0, bf16x8& pa1, bf16x8& pa2, bf16x8& pa3) {
  for (int r = 0; r < 16; ++r) p1[r] = __builtin_amdgcn_exp2f(p1[r]);
  float ps = 0; for (int r = 0; r < 16; ++r) ps += p0[r]; for (int r = 0; r < 16; ++r) ps += p1[r];
  { auto rr = __builtin_amdgcn_permlane32_swap(__float_as_uint(ps), __float_as_uint(ps), false, false);
    ps = __uint_as_float(rr[0]) + __uint_as_float(rr[1]); }
  l_reg = l_reg * alpha + ps;
#define PK4(P, BASE, OUT) do { unsigned a0 = cvtpk(P[BASE + 0], P[BASE + 1]), a1 = cvtpk(P[BASE + 2], P[BASE + 3]);   \
    unsigned b0 = cvtpk(P[BASE + 4], P[BASE + 5]), b1 = cvtpk(P[BASE + 6], P[BASE + 7]);                              \
    auto r0 = __builtin_amdgcn_permlane32_swap(a0, b0, false, false); auto r1 = __builtin_amdgcn_permlane32_swap(a1, b1, false, false); \
    u32x4 w = {r0[0], r1[0], r0[1], r1[1]}; OUT = *reinterpret_cast<bf16x8*>(&w); } while (0)
  PK4(p0, 0, pa0); PK4(p0, 8, pa1); PK4(p1, 0, pa2); PK4(p1, 8, pa3);
#undef PK4
}
__device__ __forceinline__ void qkt(f32x16& p0, f32x16& p1, const bf16* Ks, const bf16x8* qr, int r32, int hi) {
  p0 = f32x16{}; p1 = f32x16{};
  for (int d0 = 0; d0 < 8; ++d0) { int cb = (d0 * 16 + hi * 8) * 2;
    bf16x8 b0 = *reinterpret_cast<const bf16x8*>((const char*)Ks + KSWZ(r32, cb));
    bf16x8 b1 = *reinterpret_cast<const bf16x8*>((const char*)Ks + KSWZ(32 + r32, cb));
    p0 = __builtin_amdgcn_mfma_f32_32x32x16_bf16(b0, qr[d0], p0, 0, 0, 0);
    p1 = __builtin_amdgcn_mfma_f32_32x32x16_bf16(b1, qr[d0], p1, 0, 0, 0); }
}
__device__ __forceinline__ int v_st(int k, int c) { const int kk = (k & ~0xC) | ((k & 4) << 1) | ((k & 8) >> 1); return ((kk >> 3) * 4 + (c >> 5)) * 512 + ((kk & 7) * 32 + (c & 31)) * 2; }
__device__ __forceinline__ int v_rd_base(int lane) { return ((lane & 3) << 3) | (((lane >> 2) & 3) << 6) | (((lane >> 4) & 1) << 5) | (((lane >> 5) & 1) << 8); }
constexpr int v_rd_off(int d0, int ks, int half) { return d0 * 512 + ks * 4096 + half * 2048; }
template <int OFF> __device__ __forceinline__ s16x4 tr_read(int vb) {
  s16x4 r; asm volatile("ds_read_b64_tr_b16 %0, %1 offset:%2" : "=&v"(r) : "v"(vb), "i"(OFF) : "memory"); return r;
}
template <int D0> __device__ __forceinline__ void pv_one(f32x16& od, int vb, bf16x8 pa0, bf16x8 pa1, bf16x8 pa2, bf16x8 pa3) {
  const s16x4 l0 = tr_read<v_rd_off(D0, 0, 0)>(vb), h0 = tr_read<v_rd_off(D0, 0, 1)>(vb), l1 = tr_read<v_rd_off(D0, 1, 0)>(vb), h1 = tr_read<v_rd_off(D0, 1, 1)>(vb);
  const s16x4 l2 = tr_read<v_rd_off(D0, 2, 0)>(vb), h2 = tr_read<v_rd_off(D0, 2, 1)>(vb), l3 = tr_read<v_rd_off(D0, 3, 0)>(vb), h3 = tr_read<v_rd_off(D0, 3, 1)>(vb);
  asm volatile("s_waitcnt lgkmcnt(0)" ::: "memory"); SBAR();
#define PK(L, H) (bf16x8){L[0], L[1], L[2], L[3], H[0], H[1], H[2], H[3]}
  od = __builtin_amdgcn_mfma_f32_32x32x16_bf16(pa0, PK(l0, h0), od, 0, 0, 0);
  od = __builtin_amdgcn_mfma_f32_32x32x16_bf16(pa1, PK(l1, h1), od, 0, 0, 0);
  od = __builtin_amdgcn_mfma_f32_32x32x16_bf16(pa2, PK(l2, h2), od, 0, 0, 0);
  od = __builtin_amdgcn_mfma_f32_32x32x16_bf16(pa3, PK(l3, h3), od, 0, 0, 0);
#undef PK
}
__device__ __forceinline__ void pv_d0(f32x16* o, int vb, bf16x8 pa0, bf16x8 pa1, bf16x8 pa2, bf16x8 pa3) {
  pv_one<0>(o[0], vb, pa0, pa1, pa2, pa3); pv_one<1>(o[1], vb, pa0, pa1, pa2, pa3); pv_one<2>(o[2], vb, pa0, pa1, pa2, pa3); pv_one<3>(o[3], vb, pa0, pa1, pa2, pa3);
}

constexpr float THRL = THR * 1.4426950408889634f;
__device__ __forceinline__ void qkt2(f32x16& p0, f32x16& p1, const bf16* Ks, const bf16x8* qr, const f32x16& negm, int r32, int hi) {
  p0 = negm; p1 = negm;
  for (int d0 = 0; d0 < 8; ++d0) { int cb = (d0 * 16 + hi * 8) * 2;
    bf16x8 b0 = *reinterpret_cast<const bf16x8*>((const char*)Ks + KSWZ(r32, cb));
    bf16x8 b1 = *reinterpret_cast<const bf16x8*>((const char*)Ks + KSWZ(32 + r32, cb));
    p0 = __builtin_amdgcn_mfma_f32_32x32x16_bf16(b0, qr[d0], p0, 0, 0, 0);
    p1 = __builtin_amdgcn_mfma_f32_32x32x16_bf16(b1, qr[d0], p1, 0, 0, 0); }
}
template <bool FIRST> __device__ __forceinline__ void partialSM2(f32x16& p0, f32x16& p1, float& m_ref, f32x16& negm, float& alpha) {
  float pmax = p0[0]; for (int r = 1; r < 16; ++r) pmax = fmaxf(pmax, p0[r]); for (int r = 0; r < 16; ++r) pmax = fmaxf(pmax, p1[r]);
  { auto rr = __builtin_amdgcn_permlane32_swap(__float_as_uint(pmax), __float_as_uint(pmax), false, false);
    pmax = fmaxf(__uint_as_float(rr[0]), __uint_as_float(rr[1])); }
  alpha = 1.f;
  if (FIRST || __builtin_expect(!__all(pmax <= THRL), 0)) {
    const float dl = FIRST ? pmax : fmaxf(pmax, 0.f);
    m_ref += dl;
    for (int r = 0; r < 16; ++r) { p0[r] -= dl; p1[r] -= dl; }
    for (int r = 0; r < 16; ++r) negm[r] = -m_ref;
    asm volatile("" : "+v"(negm));
    if (!FIRST) alpha = __builtin_amdgcn_exp2f(-dl);
  }
}

__device__ __forceinline__ void glds16s(const void* sbase, unsigned voff, unsigned lds_dst) { unsigned keep;
  asm volatile("s_nop 4\n\ts_mov_b32 %0, m0\n\ts_mov_b32 m0, %3\n\ts_nop 0\n\tglobal_load_lds_dwordx4 %1, %2\n\ts_mov_b32 m0, %0" : "=&s"(keep) : "v"(voff), "s"(sbase), "s"(lds_dst) : "memory"); }
__device__ __forceinline__ const char* uni_ptr(const void* p) { const unsigned long long v = (unsigned long long)p;
  const unsigned lo = __builtin_amdgcn_readfirstlane((unsigned)v), hi = __builtin_amdgcn_readfirstlane((unsigned)(v >> 32)); return (const char*)(((unsigned long long)hi << 32) | lo); }

#define TRD8(D0, S) S##l0 = tr_read<v_rd_off(D0, 0, 0)>(vb), S##h0 = tr_read<v_rd_off(D0, 0, 1)>(vb), S##l1 = tr_read<v_rd_off(D0, 1, 0)>(vb), S##h1 = tr_read<v_rd_off(D0, 1, 1)>(vb), \
                    S##l2 = tr_read<v_rd_off(D0, 2, 0)>(vb), S##h2 = tr_read<v_rd_off(D0, 2, 1)>(vb), S##l3 = tr_read<v_rd_off(D0, 3, 0)>(vb), S##h3 = tr_read<v_rd_off(D0, 3, 1)>(vb)
#define PKV(L, H) (bf16x8){L[0], L[1], L[2], L[3], H[0], H[1], H[2], H[3]}
#define MM4(OD, S) do { OD = __builtin_amdgcn_mfma_f32_32x32x16_bf16(pa0, PKV(S##l0, S##h0), OD, 0, 0, 0); OD = __builtin_amdgcn_mfma_f32_32x32x16_bf16(pa1, PKV(S##l1, S##h1), OD, 0, 0, 0); \
                        OD = __builtin_amdgcn_mfma_f32_32x32x16_bf16(pa2, PKV(S##l2, S##h2), OD, 0, 0, 0); OD = __builtin_amdgcn_mfma_f32_32x32x16_bf16(pa3, PKV(S##l3, S##h3), OD, 0, 0, 0); } while (0)
__device__ __forceinline__ void pv_pipe(f32x16* o, int vb, bf16x8 pa0, bf16x8 pa1, bf16x8 pa2, bf16x8 pa3) {
  s16x4 al0, ah0, al1, ah1, al2, ah2, al3, ah3, bl0, bh0, bl1, bh1, bl2, bh2, bl3, bh3;
  TRD8(0, a);
  TRD8(1, b); asm volatile("s_waitcnt lgkmcnt(8)" ::: "memory"); SBAR(); MM4(o[0], a); SBAR();
  TRD8(2, a); asm volatile("s_waitcnt lgkmcnt(8)" ::: "memory"); SBAR(); MM4(o[1], b); SBAR();
  TRD8(3, b); asm volatile("s_waitcnt lgkmcnt(8)" ::: "memory"); SBAR(); MM4(o[2], a); SBAR();
  asm volatile("s_waitcnt lgkmcnt(0)" ::: "memory"); SBAR(); MM4(o[3], b);
}
#undef TRD8
#undef PKV
#undef MM4

#define VPRE_DECL s16x4 eal0, eah0, eal1, eah1, eal2, eah2, eal3, eah3, ebl0, ebh0, ebl1, ebh1, ebl2, ebh2, ebl3, ebh3
#define VTRD8(D0, S, VB) S##l0 = tr_read<v_rd_off(D0, 0, 0)>(VB), S##h0 = tr_read<v_rd_off(D0, 0, 1)>(VB), S##l1 = tr_read<v_rd_off(D0, 1, 0)>(VB), S##h1 = tr_read<v_rd_off(D0, 1, 1)>(VB), \
                         S##l2 = tr_read<v_rd_off(D0, 2, 0)>(VB), S##h2 = tr_read<v_rd_off(D0, 2, 1)>(VB), S##l3 = tr_read<v_rd_off(D0, 3, 0)>(VB), S##h3 = tr_read<v_rd_off(D0, 3, 1)>(VB)
#define VPKV(L, H) (bf16x8){L[0], L[1], L[2], L[3], H[0], H[1], H[2], H[3]}
#define VMM4(OD, S) do { OD = __builtin_amdgcn_mfma_f32_32x32x16_bf16(pa0, VPKV(S##l0, S##h0), OD, 0, 0, 0); OD = __builtin_amdgcn_mfma_f32_32x32x16_bf16(pa1, VPKV(S##l1, S##h1), OD, 0, 0, 0); \
                         OD = __builtin_amdgcn_mfma_f32_32x32x16_bf16(pa2, VPKV(S##l2, S##h2), OD, 0, 0, 0); OD = __builtin_amdgcn_mfma_f32_32x32x16_bf16(pa3, VPKV(S##l3, S##h3), OD, 0, 0, 0); } while (0)
#define VPRE(VB) do { VTRD8(0, ea, VB); } while (0)
#define VPOST(O, VB) do { VTRD8(1, eb, VB); asm volatile("s_waitcnt lgkmcnt(8)" ::: "memory"); SBAR(); VMM4(O[0], ea); SBAR(); \
    VTRD8(2, ea, VB); asm volatile("s_waitcnt lgkmcnt(8)" ::: "memory"); SBAR(); VMM4(O[1], eb); SBAR(); \
    VTRD8(3, eb, VB); asm volatile("s_waitcnt lgkmcnt(8)" ::: "memory"); SBAR(); VMM4(O[2], ea); SBAR(); \
    asm volatile("s_waitcnt lgkmcnt(0)" ::: "memory"); SBAR(); VMM4(O[3], eb); } while (0)
__device__ __forceinline__ void finishSM2(f32x16& p0, f32x16& p1, float alpha, float& l_reg, bf16x8& pa0, bf16x8& pa1, bf16x8& pa2, bf16x8& pa3) {
  for (int r = 0; r < 16; ++r) p0[r] = __builtin_amdgcn_exp2f(p0[r]);
  for (int r = 0; r < 16; ++r) p1[r] = __builtin_amdgcn_exp2f(p1[r]);
  float ps = 0; for (int r = 0; r < 16; ++r) ps += p0[r]; for (int r = 0; r < 16; ++r) ps += p1[r];
  { auto rr = __builtin_amdgcn_permlane32_swap(__float_as_uint(ps), __float_as_uint(ps), false, false);
    ps = __uint_as_float(rr[0]) + __uint_as_float(rr[1]); }
  l_reg = l_reg * alpha + ps;
#define PK8(P, BASE, OUT) do { u32x4 w = {cvtpk(P[BASE + 0], P[BASE + 1]), cvtpk(P[BASE + 2], P[BASE + 3]), cvtpk(P[BASE + 4], P[BASE + 5]), cvtpk(P[BASE + 6], P[BASE + 7])}; OUT = *reinterpret_cast<bf16x8*>(&w); } while (0)
  PK8(p0, 0, pa0); PK8(p0, 8, pa1); PK8(p1, 0, pa2); PK8(p1, 8, pa3);
#undef PK8
}

__device__ __forceinline__ void finishFX(f32x16& p0, f32x16& p1, float& l_part, bf16x8& pa0, bf16x8& pa1, bf16x8& pa2, bf16x8& pa3) {
  for (int r = 0; r < 16; ++r) p0[r] = __builtin_amdgcn_exp2f(p0[r]);
  for (int r = 0; r < 16; ++r) p1[r] = __builtin_amdgcn_exp2f(p1[r]);
  float ps = 0; for (int r = 0; r < 16; ++r) ps += p0[r]; for (int r = 0; r < 16; ++r) ps += p1[r];
  l_part += ps;
#define PK8(P, BASE, OUT) do { u32x4 w = {cvtpk(P[BASE + 0], P[BASE + 1]), cvtpk(P[BASE + 2], P[BASE + 3]), cvtpk(P[BASE + 4], P[BASE + 5]), cvtpk(P[BASE + 6], P[BASE + 7])}; OUT = *reinterpret_cast<bf16x8*>(&w); } while (0)
  PK8(p0, 0, pa0); PK8(p0, 8, pa1); PK8(p1, 0, pa2); PK8(p1, 8, pa3);
#undef PK8
}

template <typename TQ, bool FIXED>
__device__ __forceinline__ void attn_dense_body(const TQ* __restrict__ Qb, const bf16* __restrict__ Kh_, const bf16* __restrict__ Vh_,
                                                bf16* __restrict__ Gm, float* __restrict__ ssqa, int seq, char* lds, float refB) {
  using SQ = Stage<TQ>;
  constexpr int SLOT = (int)(SHM_V + SHM_K);
  const int tid = ltid(), wid = tid >> 6, lane = tid & 63, r32 = lane & 31, hi = lane >> 5;
  const char* Kh = uni_ptr(Kh_); const char* Vh = uni_ptr(Vh_);
  float* ws = (float*)(lds + (FIXED ? 4 : 3) * SLOT) + wid * 64; float* li_l = ws; float* al_l = ws + 32;
  float m_reg = FIXED ? refB : 0.f, l_reg = 0; f32x16 negm; for (int r = 0; r < 16; ++r) negm[r] = -m_reg; asm volatile("" : "+v"(negm));
  f32x16 o[4] = {}; bf16x8 qr[8];
  const TQ* Qw = Qb + (long)(wid * QBLK + r32) * LDQ + hi * 8;
#pragma unroll
  for (int d0 = 0; d0 < 8; ++d0) qr[d0] = SQ::tobf(SQ::ld8(Qw + d0 * 16));
  const unsigned ldsb = (unsigned)(uintptr_t)lds; const int vb0 = (int)ldsb + v_rd_base(lane);
  unsigned koff[2], voff[2];
#pragma unroll
  for (int i = 0; i < 2; ++i) { const int p = 2 * wid + i, row = 4 * p + (lane >> 4), c = (lane & 15) ^ (row & 7); koff[i] = (unsigned)(row * LDK + c * 8) * 2u;
    const int l5 = lane & 31, kk = (p >> 1) * 8 + (l5 >> 2), k = kk  , cc = (2 * (p & 1) + (lane >> 5)) * 32 + (lane & 3) * 8; voff[i] = (unsigned)(k * LDK + cc) * 2u; }
#define DMA(T, off) do { const char* kb_ = Kh + (size_t)(T) * (KVBLK * LDK * 2); const char* vb_ = Vh + (size_t)(T) * (KVBLK * LDK * 2); \
    const unsigned d_ = (unsigned)__builtin_amdgcn_readfirstlane(ldsb + (unsigned)(off) + (unsigned)wid * 2048u); \
    glds16s(vb_, voff[0], d_); glds16s(vb_, voff[1], d_ + 1024u); glds16s(kb_, koff[0], d_ + (unsigned)SHM_V); glds16s(kb_, koff[1], d_ + (unsigned)SHM_V + 1024u); } while (0)
#define WAIT_BAR() asm volatile("s_waitcnt vmcnt(0) lgkmcnt(0)\n\ts_barrier" ::: "memory")
#define RESC(a) do { if (__any((a) < 1.f)) { if (hi == 0) al_l[r32] = (a); asm volatile("s_waitcnt lgkmcnt(0)" ::: "memory"); \
    for (int d = 0; d < 4; ++d) for (int r = 0; r < 16; ++r) o[d][r] *= al_l[crow(r, hi)]; } } while (0)
#define KPTR(off) ((const bf16*)(lds + (off) + SHM_V))
#define ROT() do { const int t_ = rP; rP = rK; rK = rN; rN = t_; } while (0)
#define STEP(X0, X1, XA, Y0, Y1, YA, t, WR) do { \
    if (WR) { DMA((t) + 1, rN); } \
    SBAR(); qkt2(X0, X1, KPTR(rK), qr, negm, r32, hi); \
    if constexpr (FIXED) finishFX(Y0, Y1, l_reg, pa0, pa1, pa2, pa3); else finishSM2(Y0, Y1, YA, l_reg, pa0, pa1, pa2, pa3); SBAR(); \
    pv_pipe(o, vb0 + rP, pa0, pa1, pa2, pa3); if constexpr (!FIXED) { partialSM2<false>(X0, X1, m_reg, negm, XA); RESC(XA); } \
    WAIT_BAR(); ROT(); } while (0)
  f32x16 pA0, pA1, pB0, pB1; float alA = 1.f, alB = 1.f; bf16x8 pa0, pa1, pa2, pa3; const int NT = seq / KVBLK;
  int rP = 2 * SLOT, rK = 0, rN = SLOT;
  VPRE_DECL;
  if constexpr (FIXED) {
#define SL(t_) ((((t_)) & 3) * SLOT)
#define PVD(T, VB, WR) do { const char* kb_ = Kh + (size_t)(T) * (KVBLK * LDK * 2); const char* vb_ = Vh + (size_t)(T) * (KVBLK * LDK * 2); \
    const unsigned d_ = (unsigned)__builtin_amdgcn_readfirstlane(ldsb + (unsigned)SL(T) + (unsigned)wid * 2048u); \
    VTRD8(0, ea, VB); VTRD8(1, eb, VB); asm volatile("s_waitcnt lgkmcnt(8)" ::: "memory"); SBAR(); VMM4(o[0], ea); if (WR) glds16s(vb_, voff[0], d_); SBAR(); \
    VTRD8(2, ea, VB); asm volatile("s_waitcnt lgkmcnt(8)" ::: "memory"); SBAR(); VMM4(o[1], eb); if (WR) glds16s(vb_, voff[1], d_ + 1024u); SBAR(); \
    VTRD8(3, eb, VB); asm volatile("s_waitcnt lgkmcnt(8)" ::: "memory"); SBAR(); VMM4(o[2], ea); if (WR) glds16s(kb_, koff[0], d_ + (unsigned)SHM_V); SBAR(); \
    asm volatile("s_waitcnt lgkmcnt(0)" ::: "memory"); SBAR(); VMM4(o[3], eb); if (WR) glds16s(kb_, koff[1], d_ + (unsigned)SHM_V + 1024u); } while (0)
#define STEPF(X0, X1, Y0, Y1, t_, WR) do { \
    SBAR(); qkt2(X0, X1, KPTR(SL(t_)), qr, negm, r32, hi); finishFX(Y0, Y1, l_reg, pa0, pa1, pa2, pa3); SBAR(); \
    PVD((t_) + 2, vb0 + SL((t_) - 1), WR); \
    if (WR) asm volatile("s_waitcnt vmcnt(4) lgkmcnt(0)\n\ts_barrier" ::: "memory"); else WAIT_BAR(); } while (0)
    DMA(0, 0); DMA(1, SLOT);
    asm volatile("s_waitcnt vmcnt(4) lgkmcnt(0)\n\ts_barrier" ::: "memory");
    qkt2(pA0, pA1, KPTR(0), qr, negm, r32, hi);
    DMA(2, 2 * SLOT);
    asm volatile("s_waitcnt vmcnt(4) lgkmcnt(0)\n\ts_barrier" ::: "memory");
    int t = 1;
    for (; t + 1 <= NT - 4; t += 2) { STEPF(pB0, pB1, pA0, pA1, t, true); STEPF(pA0, pA1, pB0, pB1, t + 1, true); }
    STEPF(pB0, pB1, pA0, pA1, NT - 3, true);
    STEPF(pA0, pA1, pB0, pB1, NT - 2, false);
    STEPF(pB0, pB1, pA0, pA1, NT - 1, false);
    rP = SL(NT - 1); rK = SL(NT); rN = SL(NT + 1);
#undef STEPF
#undef PVD
#undef SL
  } else {
  DMA(0, 0); DMA(1, rN);
  asm volatile("s_waitcnt vmcnt(4) lgkmcnt(0)\n\ts_barrier" ::: "memory");
  qkt2(pA0, pA1, KPTR(rK), qr, negm, r32, hi); if constexpr (!FIXED) partialSM2<true>(pA0, pA1, m_reg, negm, alA);
  WAIT_BAR(); ROT();
  int t = 1;
  for (; t + 1 <= NT - 2; t += 2) {
    STEP(pB0, pB1, alB, pA0, pA1, alA, t, true);
    STEP(pA0, pA1, alA, pB0, pB1, alB, t + 1, true);
  }
  STEP(pB0, pB1, alB, pA0, pA1, alA, NT - 1, false);
  }
  bf16* Gw = Gm + (long)(wid * QBLK) * LDG;
  u32x4 gvv[8];
#pragma unroll
  for (int i = 0; i < 8; ++i) gvv[i] = *(const u32x4*)(Gw + (long)(i * 4 + (lane >> 4)) * LDG + (lane & 15) * 8);
  if constexpr (FIXED) { finishFX(pB0, pB1, l_reg, pa0, pa1, pa2, pa3); auto rr = __builtin_amdgcn_permlane32_swap(__float_as_uint(l_reg), __float_as_uint(l_reg), false, false); l_reg = __uint_as_float(rr[0]) + __uint_as_float(rr[1]); }
  else finishSM2(pB0, pB1, alB, l_reg, pa0, pa1, pa2, pa3);
  SBAR();
  pv_pipe(o, vb0 + rP, pa0, pa1, pa2, pa3);
  if (hi == 0) li_l[r32] = l_reg; asm volatile("s_waitcnt lgkmcnt(0)" ::: "memory");
  float rli[16];
#pragma unroll
  for (int r = 0; r < 16; ++r) rli[r] = __builtin_amdgcn_rcpf(li_l[crow(r, hi)]);
  unsigned short* stg = (unsigned short*)(lds + (wid < 4 ? rK : rN) + (wid & 3) * 8192);
#pragma unroll
  for (int r = 0; r < 16; ++r) { const int orow = crow(r, hi);
#pragma unroll
    for (int d0 = 0; d0 < 4; ++d0) { const bf16 hv = __float2bfloat16(o[d0][r] * rli[r]); stg[orow * 128 + d0 * 32 + r32] = __builtin_bit_cast(unsigned short, hv); } }
  asm volatile("s_waitcnt lgkmcnt(0)" ::: "memory");
  float* sw = ssqa + (long)(wid * QBLK) * 8;
#pragma unroll
  for (int i = 0; i < 8; ++i) { const int row = i * 4 + (lane >> 4), ch = lane & 15;
    const u32x4 ov = *(const u32x4*)(stg + row * 128 + ch * 8); u32x4* gp = (u32x4*)(Gw + (long)row * LDG + ch * 8); const u32x4 gv = gvv[i];
    float s = 0.f; u32x4 w;
#pragma unroll
    for (int k = 0; k < 4; ++k) { const float o0 = __uint_as_float(ov[k] << 16), o1 = __uint_as_float(ov[k] & 0xffff0000u), g0 = __uint_as_float(gv[k] << 16), g1 = __uint_as_float(gv[k] & 0xffff0000u);
      s += o0 * o0 + o1 * o1; w[k] = cvtpk(o0 * g0, o1 * g1); }
    *gp = w;
    s += __shfl_xor(s, 1); s += __shfl_xor(s, 2); s += __shfl_xor(s, 4); s += __shfl_xor(s, 8);
    if (ch == 0) sw[row * 8] = s; }
#undef DMA
#undef WAIT_BAR
#undef RESC
#undef KPTR
#undef ROT
#undef STEP
}

#undef KSWZ
#undef SBAR
}

#define GAS __attribute__((address_space(1)))
#define LAS __attribute__((address_space(3)))
typedef unsigned short bf16;
typedef unsigned v4u __attribute__((ext_vector_type(4)));
typedef unsigned v2u __attribute__((ext_vector_type(2)));
typedef float f32x4 __attribute__((ext_vector_type(4)));
typedef float f32x2 __attribute__((ext_vector_type(2)));
__device__ __forceinline__ unsigned f2bf(float f) { unsigned u = __builtin_bit_cast(unsigned, f); return (u + 0x7fffu + ((u >> 16) & 1u)) >> 16; }
__device__ __forceinline__ unsigned pk2(float lo, float hi) { return f2bf(lo) | (f2bf(hi) << 16); }
__device__ __forceinline__ float bflo(unsigned u) { return __uint_as_float(u << 16); }
__device__ __forceinline__ float bfhi(unsigned u) { return __uint_as_float(u & 0xffff0000u); }
__device__ __forceinline__ float bf2f(bf16 h) { return __uint_as_float((unsigned)h << 16); }
__device__ __forceinline__ float wave_sum(float v) {
#pragma unroll
    for (int o = 1; o < 64; o <<= 1) v += __shfl_xor(v, o);
    return v;
}
__device__ __forceinline__ float silu_f(float g) { return g * __builtin_amdgcn_rcpf(1.f + __expf(-g)); }
__device__ __forceinline__ float gelu_f(float v) { return 0.5f * v * (1.f + erff(v * 0.70710678118654752f)); }
__device__ __forceinline__ void unpack8(const v4u& p, float (&f)[8]) {
    f[0] = bflo(p.x); f[1] = bfhi(p.x); f[2] = bflo(p.y); f[3] = bfhi(p.y); f[4] = bflo(p.z); f[5] = bfhi(p.z); f[6] = bflo(p.w); f[7] = bfhi(p.w);
}
__device__ __forceinline__ v4u pack8(const float (&f)[8]) { v4u o; o.x = pk2(f[0], f[1]); o.y = pk2(f[2], f[3]); o.z = pk2(f[4], f[5]); o.w = pk2(f[6], f[7]); return o; }

#define RLX_AGENT __ATOMIC_RELAXED, __HIP_MEMORY_SCOPE_AGENT
#define XB_TMO      128
#define XB_XCNT(j)  (256  + 64 * (j))
#define XB_XSUB(j)  (1280 + 64 * (j))
#define XB_XGEN(j)  (2304 + 64 * (j))
#define XB_TOP      3328
#define XB_TOPGEN   3392
#define XCD_BAR_WORDS 3456
#define XB_SPIN_CAP (1u << 18)

__device__ __forceinline__ unsigned xb_ld(unsigned* p)              { return __hip_atomic_load(p, __ATOMIC_RELAXED, __HIP_MEMORY_SCOPE_AGENT); }
__device__ __forceinline__ unsigned xb_add(unsigned* p, unsigned v) { return __hip_atomic_fetch_add(p, v, __ATOMIC_RELAXED, __HIP_MEMORY_SCOPE_AGENT); }
__device__ __forceinline__ unsigned xb_xcc_id() { return (unsigned)__builtin_amdgcn_s_getreg((3 << 11) | 20) & 0xFu; }
#define XB_SPIN(cond, bar) do { unsigned _sp = 0; while (cond) { __builtin_amdgcn_s_sleep(1); \
    if ((++_sp & 255u) == 0u) { if (xb_ld(&(bar)[XB_TMO])) break; if (_sp > XB_SPIN_CAP) { atomicAdd(&(bar)[XB_TMO], 1u); break; } } } } while (0)

struct XcdBarrier {
    unsigned* bar; unsigned x;
    volatile LAS unsigned* st;
};

__device__ __forceinline__ XcdBarrier xcd_barrier_post(unsigned* bar, volatile LAS unsigned* st) {
    XcdBarrier b; b.bar = bar; b.x = xb_xcc_id(); b.st = st;
    if (threadIdx.x == 0) (void)xb_add(&bar[XB_XCNT(b.x)], 1u);
    return b;
}
__device__ __forceinline__ void xcd_barrier_complete(unsigned* bar, unsigned x, unsigned& nloc, unsigned& nx) {
    const unsigned G = gridDim.x * gridDim.y * gridDim.z;
    unsigned sum, cnt, mine, sp = 0u;
    for (;;) {
        sum = 0u; cnt = 0u; mine = 0u;
#pragma unroll
        for (unsigned j = 0; j < 16; ++j) { const unsigned c = xb_ld(&bar[XB_XCNT(j)]); sum += c; cnt += (c > 0u) ? 1u : 0u; mine = (j == x) ? c : mine; }
        if (sum == G) break;
        __builtin_amdgcn_s_sleep(1);
        if ((++sp & 255u) == 0u) { if (xb_ld(&bar[XB_TMO])) break; if (sp > XB_SPIN_CAP) { atomicAdd(&bar[XB_TMO], 1u); break; } }
    }
    nloc = mine > 0u ? mine : 1u; nx = cnt > 0u ? cnt : 1u;
}

__device__ __forceinline__ void xcd_barrier(const XcdBarrier& b) {
    asm volatile("s_waitcnt vmcnt(0)" ::: "memory");
    __syncthreads();
    if (threadIdx.x == 0) {
        unsigned* bar = b.bar;
        __builtin_amdgcn_s_waitcnt(0);
        unsigned nloc = b.st[0], nx = b.st[1];
        if (nloc == 0u) { xcd_barrier_complete(bar, b.x, nloc, nx); b.st[0] = nloc; b.st[1] = nx; }
        const unsigned old = xb_add(&bar[XB_XSUB(b.x)], 1u);
        const unsigned gen = old / nloc;
        if (old + 1u == (gen + 1u) * nloc) {
            __builtin_amdgcn_fence(__ATOMIC_RELEASE, "agent");
            asm volatile("s_waitcnt vmcnt(0)" ::: "memory");
            const unsigned og = xb_add(&bar[XB_TOP], 1u);
            const unsigned tg = og / nx;
            if (og + 1u == (tg + 1u) * nx) xb_add(&bar[XB_TOPGEN], 1u);
            else XB_SPIN(xb_ld(&bar[XB_TOPGEN]) == tg, bar);
            __builtin_amdgcn_fence(__ATOMIC_ACQUIRE, "agent");
            xb_add(&bar[XB_XGEN(b.x)], 1u);
            asm volatile("s_waitcnt vmcnt(0)" ::: "memory");
        } else {
            XB_SPIN(xb_ld(&bar[XB_XGEN(b.x)]) == gen, bar);
            __builtin_amdgcn_fence(__ATOMIC_ACQUIRE, "agent");
            asm volatile("s_waitcnt vmcnt(0)" ::: "memory");
        }
    }
    __syncthreads();
}

struct Frame {
    LAS unsigned char* lds;
    int tid, lane, wave;
    int vcu, G;
    const float *x, *norm_w, *w_in, *q_norm_w, *k_norm_w, *conv_w, *sgu_norm_w, *sgu_w, *sgu_b, *branch_norm_w, *w_out, *final_norm_w;
    float* out;
    bf16 *Win_t, *Wout_t, *XB, *Q, *K, *V, *MIX, *H, *CB, *U, *VN;
    float *SSQP, *SSQA;
    f32x2* TAB;
    bf16* WSB;
};

__host__ __device__ __forceinline__ int orig_col(int nn) {
    const int tile = nn >> 8, p256 = nn & 255, bj = p256 >> 7, pos = p256 & 127, wc = pos >> 5, fq = (pos >> 3) & 3, n = (pos >> 2) & 1, i = pos & 3;
    const int d = (wc >> 1) * 64 + n * 32 + (wc & 1) * 16 + fq * 4 + i;
    if (tile < 4) return C_Q + (tile * 2 + bj) * HD + d;
    if (tile == 4) return C_K + bj * HD + d;
    if (tile == 5) return C_V + p256;
    if (tile < 10) return C_GA + (tile - 6) * 256 + p256;
    if (tile < 14) return (n ? C_CC : C_CIN) + (tile - 10) * 128 + bj * 64 + wc * 16 + fq * 4 + i;
    if (tile < 16) return C_CB + (tile - 14) * 256 + p256;
    if (tile < 18) return C_GC + (tile - 16) * 256 + p256;
    if (tile < 20) return C_SU + (tile - 18) * 256 + p256;
    if (tile < 22) return C_SV + (tile - 20) * 256 + p256;
    return C_GS + (tile - 22) * 256 + p256;
}

struct WItem { const float* src; size_t n; const float* rs; bf16* dst; };
__device__ __forceinline__ WItem witem_make(const float* W, const float* rowscale, int N, bf16* WT, int item, int lane, bool in_proj) {
    const int nblk = N / 32, kb = item / nblk, nb = item % nblk, k0 = 64 * kb, n0 = 32 * nb, j4 = (lane & 7) * 4, oc = in_proj ? orig_col(n0 + j4) : n0 + j4;
    WItem w; w.src = W + (size_t)(k0 + (lane >> 3)) * N + oc; w.n = (size_t)N; w.rs = rowscale ? rowscale + k0 : nullptr; w.dst = WT + (size_t)n0 * LDK2 + k0; return w;
}
__device__ __forceinline__ WItem witem_of(Frame& F, int which, int it) {
    if (which == 0) return witem_make(F.w_in, F.norm_w, IN_W, F.Win_t, it, F.lane, true);
    constexpr int I_IN_ = (DM / 64) * (IN_W / 32), I_OUT_ = (MIX_W / 64) * (DM / 32);
    if (it < I_IN_) return witem_make(F.w_in + (size_t)DM * IN_W, F.norm_w + DM, IN_W, F.Win_t + (size_t)IN_W * LDK2, it, F.lane, true);
    const int r = it - I_IN_, l = r / I_OUT_;
    return witem_make(F.w_out + (size_t)l * MIX_W * DM, nullptr, DM, F.Wout_t + (size_t)l * DM * LDK2, r - l * I_OUT_, F.lane, false);
}
__device__ __forceinline__ void witem_request(const WItem& w, f32x4 (&v)[8]) {
#pragma unroll
    for (int i = 0; i < 8; ++i) v[i] = *(const f32x4*)(w.src + (size_t)(8 * i) * w.n);
}
__device__ __forceinline__ void witem_finish(const WItem& w, const f32x4 (&v)[8], LAS float* scr, int lane) {
    const int j4 = (lane & 7) * 4, c = lane & 7;
    float rsv[8];
    if (w.rs) { const f32x4 a = *(const f32x4*)(w.rs + 8 * c), b = *(const f32x4*)(w.rs + 8 * c + 4); rsv[0] = a.x; rsv[1] = a.y; rsv[2] = a.z; rsv[3] = a.w; rsv[4] = b.x; rsv[5] = b.y; rsv[6] = b.z; rsv[7] = b.w; }
    else {
#pragma unroll
        for (int j = 0; j < 8; ++j) rsv[j] = 1.f; }
#pragma unroll
    for (int i = 0; i < 8; ++i) { LAS float* d = scr + (8 * i + (lane >> 3)) * 33 + j4; d[0] = v[i].x; d[1] = v[i].y; d[2] = v[i].z; d[3] = v[i].w; }
    asm volatile("s_waitcnt lgkmcnt(0)" ::: "memory");
#pragma unroll
    for (int j = 0; j < 4; ++j) { const int n = (lane >> 3) + 8 * j; const LAS float* s = scr + (8 * c) * 33 + n;
        v4u o; o.x = pk2(s[0 * 33] * rsv[0], s[1 * 33] * rsv[1]); o.y = pk2(s[2 * 33] * rsv[2], s[3 * 33] * rsv[3]); o.z = pk2(s[4 * 33] * rsv[4], s[5 * 33] * rsv[5]); o.w = pk2(s[6 * 33] * rsv[6], s[7 * 33] * rsv[7]);
        *(GAS v4u*)(w.dst + (size_t)n * LDK2 + 8 * c) = o; }
    asm volatile("s_waitcnt lgkmcnt(0)" ::: "memory");
}
__device__ __forceinline__ void rows4_to_bf16_ssq(int lane, const float* x, bf16* xb, float* ssqp, int m, int ms, int nr) {
    f32x4 v[4][8];
#pragma unroll
    for (int r = 0; r < 4; ++r) if (r < nr) { const f32x4* xr = (const f32x4*)(x + (size_t)(m + r * ms) * DM) + lane;
#pragma unroll
        for (int j = 0; j < 8; ++j) v[r][j] = xr[64 * j]; }
#pragma unroll
    for (int r = 0; r < 4; ++r) if (r < nr) { float s = 0.f;
#pragma unroll
        for (int j = 0; j < 8; ++j) s += (v[r][j].x * v[r][j].x + v[r][j].y * v[r][j].y) + (v[r][j].z * v[r][j].z + v[r][j].w * v[r][j].w);
        s = wave_sum(s);
        v2u* o8 = (v2u*)(xb + (size_t)(m + r * ms) * LDK2) + lane;
#pragma unroll
        for (int j = 0; j < 8; ++j) { v2u o; o.x = pk2(v[r][j].x, v[r][j].y); o.y = pk2(v[r][j].z, v[r][j].w); o8[64 * j] = o; }
        if (lane < 2) ((f32x4*)(ssqp + (size_t)(m + r * ms) * 8))[lane] = (f32x4){lane == 0 ? s : 0.f, 0.f, 0.f, 0.f}; }
}
__device__ __forceinline__ float rstd_from_ssq8(const float* ssq8) {
    const f32x4 a = ((const f32x4*)ssq8)[0], b = ((const f32x4*)ssq8)[1];
    return 1.f / sqrtf((((a.x + a.y) + (a.z + a.w)) + ((b.x + b.y) + (b.z + b.w))) * (1.f / DM) + EPS);
}

constexpr int I_IN = (DM / 64) * (IN_W / 32), I_OUT = (MIX_W / 64) * (DM / 32);
__device__ __forceinline__ void convert_weights(Frame& F, int which) {
    LAS float* scr = (LAS float*)(F.lds + F.wave * 16384);
    const int gw = F.vcu * NWAVES + F.wave, NGW = F.G * NWAVES, NIT = which == 0 ? I_IN : I_IN + 2 * I_OUT;
    f32x4 va[8], vb[8]; WItem wa, wb;
    int it = gw;
    if (it < NIT) { wa = witem_of(F, which, it); witem_request(wa, va); }
    while (it < NIT) {
        int nx = it + NGW;
        if (nx < NIT) { wb = witem_of(F, which, nx); witem_request(wb, vb); }
        witem_finish(wa, va, scr, F.lane);
        it = nx; if (it >= NIT) break;
        nx = it + NGW;
        if (nx < NIT) { wa = witem_of(F, which, nx); witem_request(wa, va); }
        witem_finish(wb, vb, scr, F.lane);
        it = nx;
    }
}
__device__ __forceinline__ void phase_prologue(Frame& F) {
    const int gw = F.vcu * NWAVES + F.wave, NGW = F.G * NWAVES;
    convert_weights(F, 0);
    { const int gt = (F.vcu * NWAVES + F.wave) * 64 + F.lane;
      if (gt < 128 * 32) { const int p = gt >> 5, f = gt & 31; const float inv = powf(10000.f, -(float)(2 * f) / 64.f); const float a = (float)p * inv; float sn, cs; sincosf(a, &sn, &cs); F.TAB[gt] = (f32x2){cs, sn}; } }
    { const int gt = (F.vcu * NWAVES + F.wave) * 64 + F.lane; constexpr int N8 = DEPTH * SGU_G * CHUNK * CHUNK / 8;
      if (gt < N8) { const f32x4 a = ((const f32x4*)F.sgu_w)[2 * gt], b = ((const f32x4*)F.sgu_w)[2 * gt + 1]; v4u o; o.x = pk2(a.x, a.y); o.y = pk2(a.z, a.w); o.z = pk2(b.x, b.y); o.w = pk2(b.z, b.w); ((v4u*)F.WSB)[gt] = o; } }
    for (int m = gw; m < M; m += 4 * NGW) { const int left = (M - 1 - m) / NGW + 1; rows4_to_bf16_ssq(F.lane, F.x, F.XB, F.SSQP, m, NGW, left < 4 ? left : 4); }
}

__device__ __forceinline__ float silu_e(float v) { return v * __builtin_amdgcn_rcpf(1.f + __builtin_amdgcn_exp2f(v * -1.4426950408889634f)); }
struct EpiIn {
    static constexpr bool PERM = true, AFTER_DRAIN = false; static constexpr int MIDK = 0;
    const float* ssqp; bf16 *Q, *K, *V, *MIX, *H, *CB, *U, *VN; const float *qnw, *knw, *snw, *bw; const f32x2* tab; LAS float* P; LAS float* R; mutable int cpm;
    __device__ __forceinline__ void store8(bf16* p, const pg8::f32x4& a, const pg8::f32x4& b) const {
        pg8::u32x4 w; w.x = pg8::cvt_pk_bf16(a[0], a[1]); w.y = pg8::cvt_pk_bf16(a[2], a[3]); w.z = pg8::cvt_pk_bf16(b[0], b[1]); w.w = pg8::cvt_pk_bf16(b[2], b[3]); *(pg8::u32x4*)p = w; }
    static __device__ __forceinline__ pg8::f32x4 gelu4(const pg8::f32x4& x) { const pg8::f32x2 p = pg8::gelu_pk((pg8::f32x2){x[0], x[1]}), q = pg8::gelu_pk((pg8::f32x2){x[2], x[3]}); return (pg8::f32x4){p.x, p.y, q.x, q.y}; }
    template <bool GELU> __device__ __forceinline__ void exchange(const pg8::f32x4 (&acc)[2][2][4][2], float (&tot)[2][4][2], int wr, int wc, int fr, int fq) const {
#pragma unroll
        for (int ai = 0; ai < 2; ++ai)
#pragma unroll
            for (int m = 0; m < 4; ++m)
#pragma unroll
                for (int bj = 0; bj < 2; ++bj) { const pg8::f32x4 a = GELU ? gelu4(acc[ai][bj][m][0]) : acc[ai][bj][m][0], b = GELU ? gelu4(acc[ai][bj][m][1]) : acc[ai][bj][m][1];
                    float s = ((a[0] * a[0] + a[1] * a[1]) + (a[2] * a[2] + a[3] * a[3])) + ((b[0] * b[0] + b[1] * b[1]) + (b[2] * b[2] + b[3] * b[3]));
                    s += __shfl_xor(s, 16); s += __shfl_xor(s, 32);
                    if (fq == 0) P[((ai * 128 + wr * 64 + m * 16 + fr) * 2 + bj) * 4 + wc] = s; }
        asm volatile("s_waitcnt lgkmcnt(0)" ::: "memory"); __builtin_amdgcn_s_barrier(); asm volatile("" ::: "memory");
#pragma unroll
        for (int ai = 0; ai < 2; ++ai)
#pragma unroll
            for (int m = 0; m < 4; ++m)
#pragma unroll
                for (int bj = 0; bj < 2; ++bj) { const f32x4 q = *(const LAS f32x4*)(P + ((ai * 128 + wr * 64 + m * 16 + fr) * 2 + bj) * 4); tot[ai][m][bj] = (q.x + q.y) + (q.z + q.w); }
    }
    __device__ __forceinline__ void prep(const pg8::Unit& u, int wr, int wc, int fr, int fq) const {
        if (u.pm == cpm) return;
        asm volatile("" : "+v"(fr), "+v"(fq), "+s"(wr), "+s"(wc));
        const int t_ = (wr * 4 + wc) * 64 + fq * 16 + fr;
        if (t_ < 256) R[t_] = rstd_from_ssq8(ssqp + (size_t)(u.pm * pg8::BM + t_) * 8);
        asm volatile("s_waitcnt lgkmcnt(0)" ::: "memory"); __builtin_amdgcn_s_barrier(); asm volatile("" ::: "memory");
        cpm = u.pm;
    }
    __device__ __forceinline__ void operator()(pg8::f32x4 (&acc)[2][2][4][2], const pg8::Unit& u, int wr, int wc, int fr, int fq) const {
        asm volatile("" : "+v"(fr), "+v"(fq), "+s"(wr), "+s"(wc));
        const int pn = u.pn, row0 = u.pm * pg8::BM + wr * 64 + fr, cpos = wc * 32 + 8 * fq;
#pragma unroll
        for (int ai = 0; ai < 2; ++ai)
#pragma unroll
            for (int m = 0; m < 4; ++m) { const float rs = R[ai * 128 + wr * 64 + m * 16 + fr];
#pragma unroll
                for (int bj = 0; bj < 2; ++bj) { acc[ai][bj][m][0] *= rs; acc[ai][bj][m][1] *= rs; }
                asm volatile("" ::: "memory"); }
        const bool sgu_uv = pn >= 18 && pn < 22;
        if (sgu_uv) {
#pragma unroll
            for (int ai = 0; ai < 2; ++ai)
#pragma unroll
                for (int m = 0; m < 4; ++m)
#pragma unroll
                    for (int bj = 0; bj < 2; ++bj) { acc[ai][bj][m][0] = gelu4(acc[ai][bj][m][0]); acc[ai][bj][m][1] = gelu4(acc[ai][bj][m][1]); }
        }
        float tot[2][4][2];
        if (pn < 5 || pn == 20 || pn == 21) exchange<false>(acc, tot, wr, wc, fr, fq);
        if (pn < 5) {
            const float* wsrc = (pn < 4 ? qnw : knw) + (wc >> 1) * 64 + (wc & 1) * 16 + fq * 4;
            const f32x4 w0 = *(const f32x4*)wsrc, w1 = *(const f32x4*)(wsrc + 32);
            bf16* dst = pn < 4 ? Q + pn * 2 * HD : K; const int ld = pn < 4 ? ATTN_W : KV_W;
            const float qsc = pn < 4 ? att::SCALE * 1.4426950408889634f : 1.f;
#pragma unroll
            for (int ai = 0; ai < 2; ++ai)
#pragma unroll
                for (int m = 0; m < 4; ++m) { const int row = row0 + ai * 128 + m * 16, t = row & (SEQ - 1), p = (wc >> 1) ? (t & 63) : (t >> 6);
                    const f32x4* tp = (const f32x4*)(tab + p * 32 + (wc & 1) * 16 + fq * 4); const f32x4 t0 = tp[0], t1 = tp[1];
                    const f32x4 cs = {t0.x, t0.z, t1.x, t1.z}, sn = {t0.y, t0.w, t1.y, t1.w};
#pragma unroll
                    for (int bj = 0; bj < 2; ++bj) { const float rstd = qsc / sqrtf(tot[ai][m][bj] * (1.f / HD) + EPS);
                        const f32x4 a0 = acc[ai][bj][m][0] * rstd * w0, a1 = acc[ai][bj][m][1] * rstd * w1;
                        store8(dst + (size_t)row * ld + bj * HD + cpos, a0 * cs - a1 * sn, a1 * cs + a0 * sn); }
                    asm volatile("" ::: "memory"); }
        } else if (pn == 5 || pn == 14 || pn == 15) {
            bf16* dst = pn == 5 ? V : CB + (pn - 14) * 256; const int ld = pn == 5 ? KV_W : CONV_W;
#pragma unroll
            for (int ai = 0; ai < 2; ++ai)
#pragma unroll
                for (int m = 0; m < 4; ++m) {
#pragma unroll
                    for (int bj = 0; bj < 2; ++bj) store8(dst + (size_t)(row0 + ai * 128 + m * 16) * ld + bj * 128 + cpos, acc[ai][bj][m][0], acc[ai][bj][m][1]);
                    asm volatile("" ::: "memory"); }
        } else if (pn < 10 || pn == 16 || pn == 17 || pn >= 22) {
            const int mixc = (pn < 10 ? (pn - 6) * 256 : pn < 18 ? ATTN_W + (pn - 16) * 256 : ATTN_W + CONV_W + (pn - 22) * 256) + cpos;
            f32x4 g[2][2];
#pragma unroll
            for (int bj = 0; bj < 2; ++bj) { g[bj][0] = *(const f32x4*)(bw + mixc + bj * 128); g[bj][1] = *(const f32x4*)(bw + mixc + bj * 128 + 4); }
#pragma unroll
            for (int ai = 0; ai < 2; ++ai)
#pragma unroll
                for (int m = 0; m < 4; ++m) {
#pragma unroll
                    for (int bj = 0; bj < 2; ++bj) { pg8::f32x4 a = acc[ai][bj][m][0], b = acc[ai][bj][m][1];
#pragma unroll
                        for (int i = 0; i < 4; ++i) { a[i] = silu_e(a[i]); b[i] = silu_e(b[i]); }
                        store8(MIX + (size_t)(row0 + ai * 128 + m * 16) * LDK2 + mixc + bj * 128, a * g[bj][0], b * g[bj][1]); }
                    asm volatile("" ::: "memory"); }
        } else if (pn < 14) {
#pragma unroll
            for (int ai = 0; ai < 2; ++ai)
#pragma unroll
                for (int m = 0; m < 4; ++m) {
#pragma unroll
                    for (int bj = 0; bj < 2; ++bj) { const pg8::f32x4 h = acc[ai][bj][m][0] * acc[ai][bj][m][1];
                        v2u w; w.x = pg8::cvt_pk_bf16(h[0], h[1]); w.y = pg8::cvt_pk_bf16(h[2], h[3]);
                        *(v2u*)(H + (size_t)(row0 + ai * 128 + m * 16) * CONV_W + (pn - 10) * 128 + bj * 64 + wc * 16 + fq * 4) = w; }
                    asm volatile("" ::: "memory"); }
        } else {
            if (pn < 20) {
#pragma unroll
                for (int ai = 0; ai < 2; ++ai)
#pragma unroll
                    for (int m = 0; m < 4; ++m) {
#pragma unroll
                        for (int bj = 0; bj < 2; ++bj) store8(U + (size_t)(row0 + ai * 128 + m * 16) * SGU_W + (pn - 18) * 256 + bj * 128 + cpos, acc[ai][bj][m][0], acc[ai][bj][m][1]);
                        asm volatile("" ::: "memory"); }
            } else {
                const int c0 = (pn - 20) * 256 + cpos; f32x4 g[2][2];
#pragma unroll
                for (int bj = 0; bj < 2; ++bj) { g[bj][0] = *(const f32x4*)(snw + c0 + bj * 128); g[bj][1] = *(const f32x4*)(snw + c0 + bj * 128 + 4); }
#pragma unroll
                for (int ai = 0; ai < 2; ++ai)
#pragma unroll
                    for (int m = 0; m < 4; ++m) {
#pragma unroll
                        for (int bj = 0; bj < 2; ++bj) { const float rstd = 1.f / sqrtf(tot[ai][m][bj] * (1.f / 128.f) + EPS);
                            store8(VN + (size_t)(row0 + ai * 128 + m * 16) * SGU_W + c0 + bj * 128, acc[ai][bj][m][0] * rstd * g[bj][0], acc[ai][bj][m][1] * rstd * g[bj][1]); }
                        asm volatile("" ::: "memory"); }
            }
        }
    }
};

struct EpiOut {
    static constexpr bool PERM = true, AFTER_DRAIN = false; static constexpr int MIDK = ATTN_W / pg8::BK;
    bf16* xb; float* ssqp; LAS float* P; const float* ssqa; LAS float* R; mutable int cpm;
    __device__ __forceinline__ void prep(const pg8::Unit& u, int wr, int wc, int fr, int fq) const {
        if (u.pm == cpm) return;
        asm volatile("" : "+v"(fr), "+v"(fq), "+s"(wr), "+s"(wc));
        const int t_ = (wr * 4 + wc) * 64 + fq * 16 + fr;
        if (t_ < 256) { const float* sp = ssqa + (size_t)(u.pm * pg8::BM + t_) * 8; const f32x4 a = ((const f32x4*)sp)[0], b = ((const f32x4*)sp)[1];
            R[t_] = 1.f / sqrtf((((a.x + a.y) + (a.z + a.w)) + ((b.x + b.y) + (b.z + b.w))) * (1.f / ATTN_W) + EPS); }
        asm volatile("s_waitcnt lgkmcnt(0)" ::: "memory"); __builtin_amdgcn_s_barrier(); asm volatile("" ::: "memory");
        cpm = u.pm;
    }
    __device__ __forceinline__ void midk(pg8::f32x4 (&acc)[2][2][4][2], const pg8::Unit& u, int wr, int wc, int fr, int fq) const {
        asm volatile("" : "+v"(fr), "+v"(fq), "+s"(wr), "+s"(wc));
        const int tid_ = (wr * 4 + wc) * 64 + fq * 16 + fr;
        const bf16* pf = xb + (size_t)(u.pm * pg8::BM + (tid_ >> 1)) * LDK2 + u.pn * pg8::BM + (tid_ & 1) * 128;
        (void)*(const volatile unsigned*)pf; (void)*(const volatile unsigned*)(pf + 64);
#pragma unroll
        for (int ai = 0; ai < 2; ++ai)
#pragma unroll
            for (int m = 0; m < 4; ++m) { const float ra = R[ai * 128 + wr * 64 + m * 16 + fr];
#pragma unroll
                for (int bj = 0; bj < 2; ++bj) { acc[ai][bj][m][0] *= ra; acc[ai][bj][m][1] *= ra; } }
    }
    __device__ __forceinline__ void operator()(pg8::f32x4 (&acc)[2][2][4][2], const pg8::Unit& u, int wr, int wc, int fr, int fq) const {
        asm volatile("" : "+v"(fr), "+v"(fq), "+s"(wr), "+s"(wc));
        const int col0 = u.pn * pg8::BM + wc * 32 + 8 * fq, row0 = u.pm * pg8::BM + wr * 64 + fr;
#pragma unroll
        for (int ai = 0; ai < 2; ++ai)
#pragma unroll
            for (int m = 0; m < 4; ++m) { bf16* rp = xb + (size_t)(row0 + ai * 128 + m * 16) * LDK2 + col0; float s = 0.f;
#pragma unroll
                for (int bj = 0; bj < 2; ++bj) { const v4u q = *(const v4u*)(rp + bj * 128);
                    const pg8::f32x4 v0 = (pg8::f32x4){bflo(q.x), bfhi(q.x), bflo(q.y), bfhi(q.y)} + acc[ai][bj][m][0], v1 = (pg8::f32x4){bflo(q.z), bfhi(q.z), bflo(q.w), bfhi(q.w)} + acc[ai][bj][m][1];
                    s += ((v0[0] * v0[0] + v0[1] * v0[1]) + (v0[2] * v0[2] + v0[3] * v0[3])) + ((v1[0] * v1[0] + v1[1] * v1[1]) + (v1[2] * v1[2] + v1[3] * v1[3]));
                    v4u w; w.x = pg8::cvt_pk_bf16(v0[0], v0[1]); w.y = pg8::cvt_pk_bf16(v0[2], v0[3]); w.z = pg8::cvt_pk_bf16(v1[0], v1[1]); w.w = pg8::cvt_pk_bf16(v1[2], v1[3]); *(v4u*)(rp + bj * 128) = w; }
                s += __shfl_xor(s, 16); s += __shfl_xor(s, 32);
                if (fq == 0) P[(ai * 128 + wr * 64 + m * 16 + fr) * 4 + wc] = s; }
        asm volatile("s_waitcnt lgkmcnt(0)" ::: "memory"); __builtin_amdgcn_s_barrier(); asm volatile("" ::: "memory");
        if (wc == 0 && fq == 0) {
#pragma unroll
            for (int ai = 0; ai < 2; ++ai)
#pragma unroll
                for (int m = 0; m < 4; ++m) { const f32x4 q = *(const LAS f32x4*)(P + (ai * 128 + wr * 64 + m * 16 + fr) * 4); ssqp[(size_t)(row0 + ai * 128 + m * 16) * 8 + u.pn] = (q.x + q.y) + (q.z + q.w); }
        }
    }
};

template <bool P> struct EpiNone {
    static constexpr bool PERM = P, AFTER_DRAIN = false; static constexpr int MIDK = 0;
    __device__ __forceinline__ void prep(const pg8::Unit&, int, int, int, int) const {}
    __device__ __forceinline__ void operator()(pg8::f32x4 (&acc)[2][2][4][2], const pg8::Unit&, int, int, int, int) const {
#pragma unroll
        for (int ai = 0; ai < 2; ++ai)
#pragma unroll
            for (int bj = 0; bj < 2; ++bj)
#pragma unroll
                for (int m = 0; m < 4; ++m) asm volatile("" :: "v"(acc[ai][bj][m][0]), "v"(acc[ai][bj][m][1]));
    }
};

__device__ __forceinline__ void mix_conv_rows8(Frame& F, int l, int m0) {
    const int lane = F.lane, c = lane * 8, t0 = m0 & (SEQ - 1); const bf16* hrow = F.H + (size_t)m0 * CONV_W + c;
    const float* cw = F.conv_w + (size_t)l * CONV_W * 3 + c * 3;
    f32x4 wq[6];
#pragma unroll
    for (int j = 0; j < 6; ++j) wq[j] = *(const f32x4*)(cw + 4 * j);
    v4u hq[10], cq[8], gq[8];
    hq[0] = (t0 > 0) ? *(const v4u*)(hrow - CONV_W) : (v4u){0u, 0u, 0u, 0u};
#pragma unroll
    for (int j = 0; j < 8; ++j) hq[1 + j] = *(const v4u*)(hrow + (size_t)j * CONV_W);
    hq[9] = (t0 + 8 < SEQ) ? *(const v4u*)(hrow + (size_t)8 * CONV_W) : (v4u){0u, 0u, 0u, 0u};
    bf16* mp = F.MIX + (size_t)m0 * LDK2 + ATTN_W + c;
#pragma unroll
    for (int j = 0; j < 8; ++j) { cq[j] = *(const v4u*)(F.CB + (size_t)(m0 + j) * CONV_W + c); gq[j] = *(const v4u*)(mp + (size_t)j * LDK2); }
    float w[24];
#pragma unroll
    for (int j = 0; j < 6; ++j) { w[4 * j] = wq[j].x; w[4 * j + 1] = wq[j].y; w[4 * j + 2] = wq[j].z; w[4 * j + 3] = wq[j].w; }
#pragma unroll
    for (int j = 0; j < 8; ++j) {
        float hm[8], h0[8], hp[8], cb[8], g[8], o[8]; unpack8(hq[j], hm); unpack8(hq[j + 1], h0); unpack8(hq[j + 2], hp); unpack8(cq[j], cb); unpack8(gq[j], g);
        float s = 0.f;
#pragma unroll
        for (int k = 0; k < 8; ++k) { const float y = hm[k] * w[3 * k] + h0[k] * w[3 * k + 1] + hp[k] * w[3 * k + 2]; o[k] = cb[k] * y; s += o[k] * o[k]; }
        const float rstd = 1.f / sqrtf(wave_sum(s) * (1.f / CONV_W) + EPS);
        float r[8];
#pragma unroll
        for (int k = 0; k < 8; ++k) r[k] = o[k] * rstd * g[k];
        *(v4u*)(mp + (size_t)j * LDK2) = pack8(r); }
}
__device__ __forceinline__ void mix_sgu_unit(Frame& F, int l, int unit, char* lds_generic) {
    constexpr int VT_BYTES = 16384, OST_OFF = 2 * VT_BYTES;
    const int lane = F.lane, wave = F.wave, tid = F.tid, r32 = lane & 31, hi = lane >> 5; const size_t r0 = (size_t)(unit >> 1) * CHUNK; const int ph0 = (unit & 1) * 64;
    const int sr = tid >> 4, sc = (tid & 15) * 8, vst0 = att::v_st(sr, sc), vst1 = att::v_st(32 + sr, sc);
    const int vb0 = (int)(uintptr_t)lds_generic + att::v_rd_base(lane);
    const int wp = wave & 1, wd = wave >> 1;
    LAS float* ost = (LAS float*)(F.lds + OST_OFF + wave * 4096);
    v4u vn[4];
#pragma unroll
    for (int t = 0; t < 2; ++t) { const bf16* vp = F.VN + (r0 + 64 * t) * SGU_W + sc; vn[2 * t] = *(const v4u*)(vp + (size_t)sr * SGU_W); vn[2 * t + 1] = *(const v4u*)(vp + (size_t)(32 + sr) * SGU_W); }
#pragma unroll 1
    for (int g = 0; g < SGU_G; ++g) {
#pragma unroll
        for (int t = 0; t < 2; ++t) { *(LAS v4u*)(F.lds + t * VT_BYTES + vst0) = vn[2 * t]; *(LAS v4u*)(F.lds + t * VT_BYTES + vst1) = vn[2 * t + 1]; }
        bf16* upb = F.U + (r0 + ph0 + wp * 32 + (lane >> 3)) * SGU_W + g * 128 + wd * 32 + (lane & 7) * 4;
        v2u uu[4];
#pragma unroll
        for (int i = 0; i < 4; ++i) uu[i] = *(const v2u*)(upb + (size_t)(i * 8) * SGU_W);
        const bf16* Wrow = F.WSB + (((size_t)l * SGU_G + g) * CHUNK + ph0 + wp * 32 + r32) * CHUNK + hi * 8;
        att::bf16x8 pw[2][4];
#pragma unroll
        for (int t = 0; t < 2; ++t)
#pragma unroll
            for (int q = 0; q < 4; ++q) pw[t][q] = *(const att::bf16x8*)(Wrow + 64 * t + 16 * q);
        if (g + 1 < SGU_G) {
#pragma unroll
            for (int t = 0; t < 2; ++t) { const bf16* vp = F.VN + (r0 + 64 * t) * SGU_W + (g + 1) * 128 + sc; vn[2 * t] = *(const v4u*)(vp + (size_t)sr * SGU_W); vn[2 * t + 1] = *(const v4u*)(vp + (size_t)(32 + sr) * SGU_W); } }
        asm volatile("s_waitcnt lgkmcnt(0)" ::: "memory"); __builtin_amdgcn_s_barrier(); asm volatile("" ::: "memory");
        att::f32x16 o0 = {};
#pragma unroll
        for (int t = 0; t < 2; ++t) {
            if (wd == 0) att::pv_one<0>(o0, vb0 + t * VT_BYTES, pw[t][0], pw[t][1], pw[t][2], pw[t][3]); else if (wd == 1) att::pv_one<1>(o0, vb0 + t * VT_BYTES, pw[t][0], pw[t][1], pw[t][2], pw[t][3]);
            else if (wd == 2) att::pv_one<2>(o0, vb0 + t * VT_BYTES, pw[t][0], pw[t][1], pw[t][2], pw[t][3]); else att::pv_one<3>(o0, vb0 + t * VT_BYTES, pw[t][0], pw[t][1], pw[t][2], pw[t][3]); }
        const float* bg = F.sgu_b + ((size_t)l * SGU_G + g) * CHUNK + ph0 + wp * 32;
#pragma unroll
        for (int r = 0; r < 16; ++r) { const int pr = att::crow(r, hi); ost[pr * 32 + r32] = o0[r] + bg[pr]; }
        asm volatile("s_waitcnt lgkmcnt(0)" ::: "memory");
#pragma unroll
        for (int i = 0; i < 4; ++i) { const int pr = i * 8 + (lane >> 3), c4 = (lane & 7) * 4; const f32x4 sv = *(const LAS f32x4*)(ost + pr * 32 + c4);
            v2u w; w.x = pk2(bflo(uu[i].x) * sv.x, bfhi(uu[i].x) * sv.y); w.y = pk2(bflo(uu[i].y) * sv.z, bfhi(uu[i].y) * sv.w); *(v2u*)(upb + (size_t)(i * 8) * SGU_W) = w; }
        __syncthreads();
    }
    { const size_t mb = r0 + ph0 + wave; const int c = lane * 8;
      v4u oq[8], gq[8];
#pragma unroll
      for (int i = 0; i < 8; ++i) { oq[i] = *(const v4u*)(F.U + (mb + 8 * i) * SGU_W + c); gq[i] = *(const v4u*)(F.MIX + (mb + 8 * i) * LDK2 + ATTN_W + CONV_W + c); }
#pragma unroll
      for (int i = 0; i < 8; ++i) { float o[8], g[8]; unpack8(oq[i], o); unpack8(gq[i], g);
        float s = 0.f;
#pragma unroll
        for (int k = 0; k < 8; ++k) s += o[k] * o[k];
        const float rstd = 1.f / sqrtf(wave_sum(s) * (1.f / SGU_W) + EPS);
        float r[8];
#pragma unroll
        for (int k = 0; k < 8; ++k) r[k] = o[k] * rstd * g[k];
        *(v4u*)(F.MIX + (mb + 8 * i) * LDK2 + ATTN_W + CONV_W + c) = pack8(r); } }
}
__device__ __forceinline__ void phase_mixer(Frame& F, int l, char* lds_generic) {
    constexpr int NUNITS = BATCH * NQH * (SEQ / 256);
    const int upc = (NUNITS + F.G - 1) / F.G;
    float refB;
    { const float* qw = F.q_norm_w + l * HD; const float* kw = F.k_norm_w + l * HD; float a = fmaxf(fabsf(qw[2 * F.lane]), fabsf(qw[2 * F.lane + 1])), b = fmaxf(fabsf(kw[2 * F.lane]), fabsf(kw[2 * F.lane + 1]));
#pragma unroll
      for (int o_ = 1; o_ < 64; o_ <<= 1) { a = fmaxf(a, __shfl_xor(a, o_)); b = fmaxf(b, __shfl_xor(b, o_)); }
      refB = 128.f * att::SCALE * 1.4426950408889634f * 1.02f * a * b; refB = __builtin_bit_cast(float, __builtin_amdgcn_readfirstlane(__builtin_bit_cast(int, refB))); }
    const bool tail_first = ((F.vcu >> 4) & 1) != 0;
#pragma unroll 1
    for (int pass = 0; pass < 2; ++pass) {
      if ((pass == 0) != tail_first) {
        for (int i = 0; i < upc; ++i) {
            const int u = F.vcu * upc + i; if (u >= NUNITS) break;
            const int bkv = u >> 7, rem = u & 127, hh = rem >> 5, qb = rem & 31;
            const int b = bkv >> 1, kvh = bkv & 1, h = kvh * 4 + hh; const size_t row0 = (size_t)b * SEQ + qb * 256;
            const att::bf16* Qb = (const att::bf16*)F.Q + row0 * ATTN_W + h * HD;
            const att::bf16* Kh = (const att::bf16*)F.K + (size_t)b * SEQ * KV_W + kvh * HD; const att::bf16* Vh = (const att::bf16*)F.V + (size_t)b * SEQ * KV_W + kvh * HD;
            if (refB <= 60.f) att::attn_dense_body<att::bf16, true>(Qb, Kh, Vh, (att::bf16*)F.MIX + row0 * LDK2 + h * HD, F.SSQA + row0 * 8 + h, SEQ, lds_generic, refB);
            else att::attn_dense_body<att::bf16, false>(Qb, Kh, Vh, (att::bf16*)F.MIX + row0 * LDK2 + h * HD, F.SSQA + row0 * 8 + h, SEQ, lds_generic, 0.f);
            __syncthreads();
        }
      } else {
        F.tid = ltid(); F.lane = F.tid & 63;
        for (int u = F.vcu; u < 2 * (M / CHUNK); u += F.G) mix_sgu_unit(F, l, u, lds_generic);
        { const int gw = F.vcu * NWAVES + F.wave, NGW = F.G * NWAVES; for (int m8 = gw; m8 < M / 8; m8 += NGW) mix_conv_rows8(F, l, m8 * 8); }
        if (l == 0) { __syncthreads(); convert_weights(F, 1); }
      }
      __syncthreads();
    }
}

__device__ __forceinline__ void phase_final(Frame& F) {
    const int gw = F.vcu * NWAVES + F.wave, NGW = F.G * NWAVES, lane = F.lane;
    for (int m = gw; m < M; m += NGW) { const float rstd = rstd_from_ssq8(F.SSQP + (size_t)m * 8);
        const bf16* xr = F.XB + (size_t)m * LDK2 + lane * 8; float* orow = F.out + (size_t)m * DM + lane * 8; const float* wr = F.final_norm_w + lane * 8;
#pragma unroll
        for (int j = 0; j < 4; ++j) { float v[8]; unpack8(*(const v4u*)(xr + j * 512), v); const f32x4 w0 = *(const f32x4*)(wr + j * 512), w1 = *(const f32x4*)(wr + j * 512 + 4);
            *(f32x4*)(orow + j * 512) = (f32x4){v[0], v[1], v[2], v[3]} * rstd * w0; *(f32x4*)(orow + j * 512 + 4) = (f32x4){v[4], v[5], v[6], v[7]} * rstd * w1; } }
}

struct Args { const float* in[12]; float* out; unsigned char* ws; int ph_lo, ph_hi; };
constexpr int PH_PER_LAYER = 3, N_PHASES = 2 + DEPTH * PH_PER_LAYER;
__global__ void __launch_bounds__(NWAVES * 64, 2) fwd(Args args) {
    extern __shared__ __attribute__((aligned(16))) unsigned char lds[];
    Frame F;
    F.lds = (LAS unsigned char*)lds;
    F.G = gridDim.x; { const int bx = blockIdx.x; F.vcu = (F.G % 8 == 0) ? (bx % 8) * (F.G / 8) + bx / 8 : bx; }
    unsigned char* ws = args.ws;
    const int lo = args.ph_lo, hi = args.ph_hi;
    for (int u = threadIdx.x; u < 64; u += NWAVES * 64) ((LAS unsigned*)(F.lds + MISC_OFF))[u] = 0u;
    __syncthreads();
    const XcdBarrier bar = xcd_barrier_post((unsigned*)(ws + WS_CTL) + CW_BAR, (volatile LAS unsigned*)(F.lds + MISC_OFF) + 8);
#define SEAM(k) do { if (lo <= (k) && (k) + 1 < hi) xcd_barrier(bar); } while (0)
#define IN(k) (lo <= (k) && (k) < hi)
    typedef const __attribute__((address_space(4))) Args* KArgP;
    const KArgP kap = (KArgP)__builtin_amdgcn_kernarg_segment_ptr();
#define PHASE_IDS() do { KArgP ap_ = kap; asm volatile("" : "+s"(ap_)); unsigned char* ws_ = ap_->ws; \
    F.tid = ltid(); F.lane = F.tid & 63; F.wave = __builtin_amdgcn_readfirstlane(F.tid >> 6); \
    F.x = ap_->in[0]; F.norm_w = ap_->in[1]; F.w_in = ap_->in[2]; F.q_norm_w = ap_->in[3]; F.k_norm_w = ap_->in[4]; F.conv_w = ap_->in[5]; \
    F.sgu_norm_w = ap_->in[6]; F.sgu_w = ap_->in[7]; F.sgu_b = ap_->in[8]; F.branch_norm_w = ap_->in[9]; F.w_out = ap_->in[10]; F.final_norm_w = ap_->in[11]; F.out = ap_->out; \
    F.TAB = (f32x2*)(ws_ + WS_TAB); F.WSB = (bf16*)(ws_ + WS_WSB); F.SSQP = (float*)(ws_ + WS_SSQP); F.Win_t = (bf16*)(ws_ + WS_WIN); F.Wout_t = (bf16*)(ws_ + WS_WOUT); F.XB = (bf16*)(ws_ + WS_XB); \
    F.Q = (bf16*)(ws_ + WS_Q); F.K = (bf16*)(ws_ + WS_K); F.V = (bf16*)(ws_ + WS_V); F.MIX = (bf16*)(ws_ + WS_MIX); F.H = (bf16*)(ws_ + WS_H); F.CB = (bf16*)(ws_ + WS_CB); F.U = (bf16*)(ws_ + WS_U); \
    F.VN = (bf16*)(ws_ + WS_VN); F.SSQA = (float*)(ws_ + WS_SSQA); } while (0)
#ifndef SK0
    if (IN(0)) { PHASE_IDS(); phase_prologue(F); }
#endif
    SEAM(0);
#pragma unroll 1
    for (int l = 0; l < DEPTH; ++l) {
        const int pb = 1 + l * PH_PER_LAYER;
#ifndef SK1
        if (IN(pb + 0)) { PHASE_IDS();
            pg8::Gemm g{F.XB, F.Win_t + (size_t)l * IN_W * LDK2, M, IN_W, DM, LDK2}; pg8::StaticOrder S; S.init(M, IN_W, F.G, (int)blockIdx.x);
            EpiIn E{F.SSQP, F.Q, F.K, F.V, F.MIX, F.H, F.CB, F.U, F.VN, F.q_norm_w + l * HD, F.k_norm_w + l * HD, F.sgu_norm_w + l * SGU_W, F.branch_norm_w + l * MIX_W, F.TAB, (LAS float*)(F.lds + XCH_OFF), (LAS float*)(F.lds + MISC_OFF + 2048), -1};
            pg8::gemm_phase<EpiIn, pg8::StaticOrder, true, true>(F.lds, g, S, E);
        }
#endif
        SEAM(pb + 0);
#ifndef SK2
        if (IN(pb + 1)) { PHASE_IDS(); phase_mixer(F, l, (char*)lds); }
#endif
        SEAM(pb + 1);
#ifndef SK4
        if (IN(pb + 2)) { PHASE_IDS();
            pg8::Gemm g{F.MIX, F.Wout_t + (size_t)l * DM * LDK2, M, DM, MIX_W, LDK2}; pg8::StaticOrder S; S.init(M, DM, F.G, (int)blockIdx.x);
            EpiOut E{F.XB, F.SSQP, (LAS float*)(F.lds + XCH_OFF), F.SSQA, (LAS float*)(F.lds + MISC_OFF + 2048), -1};
            pg8::gemm_phase<EpiOut, pg8::StaticOrder, true, true>(F.lds, g, S, E);
        }
#endif
        SEAM(pb + 2);
    }
#ifndef SK5
    if (IN(N_PHASES - 1)) { PHASE_IDS(); phase_final(F); }
#endif
#undef IN
}

extern "C" void kernel_launch(void* const* d_in, const int* in_sizes, int n_in, void* d_out, int out_size, void* d_ws, size_t ws_size, hipStream_t stream) {
    static int grid = 0;
    if (grid == 0) {
        if (n_in != 12 || in_sizes[0] != M * DM || out_size != M * DM || ws_size < WS_END) { fprintf(stderr, "kernel_launch: shape mismatch (n_in %d, in0 %d, out %d, ws %zu; need ws >= %zu)\n", n_in, n_in > 0 ? in_sizes[0] : -1, out_size, ws_size, (size_t)WS_END); grid = -1; return; }
        int dev = 0, cus = 0;
        if (hipGetDevice(&dev) != hipSuccess || hipDeviceGetAttribute(&cus, hipDeviceAttributeMultiprocessorCount, dev) != hipSuccess) { grid = -1; return; }
        if (hipFuncSetAttribute((const void*)fwd, hipFuncAttributeMaxDynamicSharedMemorySize, LDS_BYTES) != hipSuccess) { fprintf(stderr, "kernel_launch: hipFuncSetAttribute failed\n"); grid = -1; return; }
        int per_cu = 0;
        if (hipOccupancyMaxActiveBlocksPerMultiprocessor(&per_cu, (const void*)fwd, NWAVES * 64, LDS_BYTES) != hipSuccess || per_cu < 1) { fprintf(stderr, "kernel_launch: occupancy query says %d blocks per CU\n", per_cu); (void)hipGetLastError(); }
        grid = cus;
    }
    if (grid < 0) return;
    Args a{};
    for (int i = 0; i < 12; ++i) a.in[i] = (const float*)d_in[i];
    a.out = (float*)d_out; a.ws = (unsigned char*)d_ws;
    a.ph_lo = 0; a.ph_hi = N_PHASES;
    if (hipMemsetAsync((char*)d_ws + WS_CTL, 0, CTL_ZERO_BYTES, stream) != hipSuccess) { fprintf(stderr, "kernel_launch: hipMemsetAsync failed\n"); return; }
    hipLaunchKernelGGL(fwd, dim3(grid), dim3(NWAVES * 64), LDS_BYTES, stream, a);
}
```

```cpp
#include <hip/hip_runtime.h>
#include <hip/hip_bf16.h>
#include <cstdio>
#include <cstdint>
#include <cmath>
constexpr int BATCH = 2, SEQ = 8192, DM = 2048, DEPTH = 2, M = BATCH * SEQ;
constexpr int HD = 128, NQH = 8, NKVH = 2, ATTN_W = 1024, KV_W = 256, CONV_W = 512, SGU_W = 512, SGU_G = 4, CHUNK = 128, IN_W = 6144, MIX_W = 2048;
constexpr int C_Q = 0, C_K = 1024, C_V = 1280, C_GA = 1536, C_CIN = 2560, C_CB = 3072, C_CC = 3584, C_GC = 4096, C_SU = 4608, C_SV = 5120, C_GS = 5632;
constexpr float EPS = 1e-6f;
constexpr int NWAVES = 8, LDS_BYTES = 147456;
constexpr int RING_BYTES = 131072, XCH_OFF = RING_BYTES, MISC_OFF = RING_BYTES + 8192;
constexpr int CW_BAR = 4096; constexpr size_t CTL_ZERO_BYTES = 65536;
constexpr size_t MiB = 1u << 20;
#ifndef PADK
#define PADK 0
#endif
constexpr int LDK2 = DM + PADK;
constexpr size_t WS_CTL = 0, WS_TAB = 1 * MiB, WS_WSB = 1 * MiB + 64 * 1024, WS_SSQP = 1 * MiB + 512 * 1024, WS_WIN = 2 * MiB, WS_WOUT = 52 * MiB, WS_XB = 70 * MiB, WS_Q = 136 * MiB, WS_K = 168 * MiB, WS_V = 176 * MiB,
                 WS_MIX = 184 * MiB, WS_H = 250 * MiB, WS_CB = 266 * MiB, WS_U = 282 * MiB, WS_VN = 298 * MiB, WS_SSQA = 314 * MiB, WS_END = 315 * MiB;
static_assert(WS_WIN + (size_t)DEPTH * IN_W * LDK2 * 2 <= WS_WOUT && WS_WOUT + (size_t)DEPTH * DM * LDK2 * 2 <= WS_XB && WS_XB + (size_t)M * LDK2 * 2 <= WS_Q && WS_Q + (size_t)M * ATTN_W * 2 <= WS_K && WS_K + (size_t)M * KV_W * 2 <= WS_V
              && WS_V + (size_t)M * KV_W * 2 <= WS_MIX && WS_MIX + (size_t)M * LDK2 * 2 <= WS_H && WS_H + (size_t)M * CONV_W * 2 <= WS_CB && WS_CB + (size_t)M * CONV_W * 2 <= WS_U && WS_U + (size_t)M * SGU_W * 2 <= WS_VN
              && WS_VN + (size_t)M * SGU_W * 2 <= WS_SSQA && WS_SSQA + (size_t)M * 8 * 4 <= WS_END && WS_SSQP + (size_t)M * 8 * 4 <= WS_WIN && WS_TAB + 128 * 32 * 8 <= WS_WSB && WS_WSB + (size_t)DEPTH * SGU_G * CHUNK * CHUNK * 2 <= WS_SSQP, "d_ws map");
#define ATT_LDQ 1024
#define ATT_LDK 256
#define ATT_LDO 1024
#define ATT_LDG LDK2
__device__ __forceinline__ int ltid() { int t = threadIdx.x; asm volatile("" : "+v"(t)); return t; }
namespace pg8 {
#define PG8_LAS __attribute__((address_space(3)))
typedef unsigned short bf16_t;
typedef short bf16x8 __attribute__((ext_vector_type(8)));
typedef float f32x4 __attribute__((ext_vector_type(4)));
typedef unsigned u32x4 __attribute__((ext_vector_type(4)));
constexpr int BM = 256, BK = 64, HALF = 128, HTB = HALF * BK * 2  , STAGE_BYTES = 8 * HTB, NXCD = 8, WGM = 8;

__host__ __device__ __forceinline__ int lds_byte(int r, int c) { const int st = (r >> 4) * 2 + (c >> 5), rr = r & 15, cc = c & 31, ob = rr * 64 + cc * 2; return st * 1024 + (ob ^ (((ob >> 9) & 1) << 5)); }
__host__ __device__ __forceinline__ void stage_rc(int b, int& R, int& C) { const int st = b / 1024, sb = b % 1024, swz = sb ^ (((sb >> 9) & 1) << 5); R = (st >> 1) * 16 + swz / 64; C = (st & 1) * 32 + (swz % 64) / 2; }
__host__ __device__ __forceinline__ int perm32(int rho) { const int n = rho >> 4, i = rho & 15; return 8 * (i >> 2) + 4 * n + (i & 3); }

struct Unit { int pm, pn; };
struct Gemm { const bf16_t* A; const bf16_t* Bt; int M, N, K, ld; };

struct StaticOrder {
    int nM, nN, nwg, G, c;
    __host__ __device__ void init(int M, int N, int G_, int c_) { nM = M / BM; nN = N / BM; nwg = nM * nN; G = G_; c = c_; }
    __host__ __device__ bool next(int i, Unit& u) const {
        const long L = (long)i * G + c; if (L >= nwg) return false;
        int wgid = (int)L; { const int q = nwg / NXCD, r = nwg % NXCD, xcd = wgid % NXCD, off = wgid / NXCD; wgid = (xcd < r ? xcd * (q + 1) : r * (q + 1) + (xcd - r) * q) + off; }
        const int nig = WGM * nN, gid = wgid / nig, fm = gid * WGM, gsz = (nM - fm) < WGM ? (nM - fm) : WGM;
        u.pm = fm + ((wgid % nig) % gsz); u.pn = (wgid % nig) / gsz; return true;
    }
    __device__ __forceinline__ void a_ready(const Unit&) const {}
    __device__ __forceinline__ void done(const Unit&) const {}
};

__device__ __forceinline__ unsigned cvt_pk_bf16(float lo, float hi) { unsigned r; asm volatile("v_cvt_pk_bf16_f32 %0, %1, %2" : "=v"(r) : "v"(lo), "v"(hi)); return r; }
typedef float f32x2 __attribute__((ext_vector_type(2)));
__device__ __forceinline__ f32x2 gelu_pk(f32x2 v) {
    const f32x2 av = __builtin_elementwise_abs(v), d = av * 0.2316418882f + 1.0f;
    f32x2 t; t.x = __builtin_amdgcn_rcpf(d.x); t.y = __builtin_amdgcn_rcpf(d.y);
    f32x2 q = t * 0.5307027145f + (-0.7265760135f); q = q * t + 0.7107068705f; q = q * t + (-0.142248368f); q = q * t + 0.127414796f; q = q * t;
    const f32x2 s = (v * v) * (-0.72134752044f);
    f32x2 e; e.x = __builtin_amdgcn_exp2f(s.x); e.y = __builtin_amdgcn_exp2f(s.y);
    const f32x2 m = v * (q * e), r = v - m;
    f32x2 o; o.x = v.x < 0.f ? m.x : r.x; o.y = v.y < 0.f ? m.y : r.y; return o;
}

template <int ACT  > struct EpiBf16 {
    static constexpr bool PERM = true, AFTER_DRAIN = false; static_assert(ACT == 0 || ACT == 1, "EpiBf16: ACT is 0 (none) or 1 (gelu_pk)");
    bf16_t* O; int ldc; const float* bias; int split_cols; size_t split_stride; float scale0;
    __device__ __forceinline__ void operator()(const f32x4 (&acc)[2][2][4][2], const Unit& u, int wr, int wc, int fr, int fq) const {
        const int row0 = u.pm * BM + wr * 64 + fr; int colt = u.pn * BM; bf16_t* base = O;
        float sc = 1.f; if (split_cols) { const int t = colt / split_cols; base += (size_t)t * split_stride; colt -= t * split_cols; if (t == 0) sc = scale0; }
        const int col0 = colt + wc * 32 + 8 * fq, bcol0 = u.pn * BM + wc * 32 + 8 * fq;
        f32x4 bv[2][2];
#pragma unroll
        for (int bj = 0; bj < 2; ++bj)
#pragma unroll
            for (int n = 0; n < 2; ++n) bv[bj][n] = bias ? *(const f32x4*)(bias + bcol0 + bj * HALF + 4 * n) : (f32x4){0.f, 0.f, 0.f, 0.f};
#pragma unroll
        for (int ai = 0; ai < 2; ++ai)
#pragma unroll
            for (int m = 0; m < 4; ++m) { bf16_t* rowp = base + (size_t)(row0 + ai * HALF + m * 16) * ldc + col0;
#pragma unroll
                for (int bj = 0; bj < 2; ++bj) { f32x4 v0 = acc[ai][bj][m][0] + bv[bj][0], v1 = acc[ai][bj][m][1] + bv[bj][1];
                    if (ACT == 1) { f32x2 a = gelu_pk((f32x2){v0[0], v0[1]}), b = gelu_pk((f32x2){v0[2], v0[3]}), c = gelu_pk((f32x2){v1[0], v1[1]}), d = gelu_pk((f32x2){v1[2], v1[3]});
                        v0 = (f32x4){a.x, a.y, b.x, b.y}; v1 = (f32x4){c.x, c.y, d.x, d.y}; }
                    v0 = v0 * sc; v1 = v1 * sc; u32x4 w; w.x = cvt_pk_bf16(v0[0], v0[1]); w.y = cvt_pk_bf16(v0[2], v0[3]); w.z = cvt_pk_bf16(v1[0], v1[1]); w.w = cvt_pk_bf16(v1[2], v1[3]);
                    *(u32x4*)(rowp + bj * HALF) = w; } }
    }
};
template <class Epi, class Sched, bool ALIGN_EPI = false, bool SP2 = false>
__device__ __forceinline__ void gemm_phase(PG8_LAS unsigned char* lds, const Gemm g, const Sched& S, const Epi& E) {
    const int tid = ltid(), wid = __builtin_amdgcn_readfirstlane(tid >> 6), lane = tid & 63, wr = wid >> 2, wc = wid & 3, fr = lane & 15, fq = lane >> 4;
    const int K = g.K, nt = K / BK, LD = g.ld;
    unsigned voffA[2], voffB[2];
#pragma unroll
    for (int i = 0; i < 2; ++i) { int R, C; stage_rc(tid * 16 + i * 8192, R, C); const int Rb = Epi::PERM ? ((R & ~31) + perm32(R & 31)) : R;
        voffA[i] = (unsigned)(R * LD + C) * 2u; voffB[i] = (unsigned)(Rb * LD + C) * 2u; }
    const size_t kstep = (size_t)(BK * 2);
    const size_t hstep = (size_t)HALF * LD * 2;
    const size_t tstep = 2 * hstep;
    const unsigned ldsw = (unsigned)wid * 1024u;
    const int aoff = lds_byte(wr * 64 + fr, fq * 8), boff = lds_byte(wc * 32 + fr, fq * 8);
#define PG8_SA(b, h) (((b) * 2 + (h)) * HTB)
#define PG8_SB(b, h) ((4 + (b) * 2 + (h)) * HTB)
#define PG8_STAGE(bufoff, gbase, voff) do { _Pragma("unroll") for (int _i = 0; _i < 2; ++_i) \
        __builtin_amdgcn_global_load_lds((const unsigned*)((const char*)(gbase) + (voff)[_i]), (PG8_LAS unsigned*)(lds + (bufoff) + ldsw + _i * 8192), 16, 0, 0); } while (0)
#define PG8_LDA(dst, b, h) do { _Pragma("unroll") for (int m = 0; m < 4; ++m) _Pragma("unroll") for (int k = 0; k < 2; ++k) dst[m][k] = *(const PG8_LAS bf16x8*)(lds + PG8_SA(b, h) + aoff + m * 2048 + k * 1024); } while (0)
#define PG8_LDB(dst, b, h) do { _Pragma("unroll") for (int n = 0; n < 2; ++n) _Pragma("unroll") for (int k = 0; k < 2; ++k) dst[n][k] = *(const PG8_LAS bf16x8*)(lds + PG8_SB(b, h) + boff + n * 2048 + k * 1024); } while (0)
#define PG8_MMA(ai, bj, At, Bt) do { __builtin_amdgcn_s_setprio(1); _Pragma("unroll") for (int m = 0; m < 4; ++m) _Pragma("unroll") for (int n = 0; n < 2; ++n) _Pragma("unroll") for (int k = 0; k < 2; ++k) \
        acc[ai][bj][m][n] = __builtin_amdgcn_mfma_f32_16x16x32_bf16(Bt[n][k], At[m][k], acc[ai][bj][m][n], 0, 0, 0); __builtin_amdgcn_s_setprio(0); } while (0)
#define PG8_WAIT_V(n) asm volatile("s_waitcnt vmcnt(" #n ")" ::: "memory")
#define PG8_WAIT_L(n) asm volatile("s_waitcnt lgkmcnt(" #n ")" ::: "memory")
#define PG8_BAR __builtin_amdgcn_s_barrier()
#define PG8_SCHED __builtin_amdgcn_sched_barrier(0)
    Unit cur, nxt; int ui = 0;
    if (!S.next(0, cur)) return;
    f32x4 acc[2][2][4][2];
#pragma unroll
    for (int a = 0; a < 2; ++a)
#pragma unroll
        for (int b = 0; b < 2; ++b)
#pragma unroll
            for (int m = 0; m < 4; ++m)
#pragma unroll
                for (int n = 0; n < 2; ++n) acc[a][b][m][n] = (f32x4){0.f, 0.f, 0.f, 0.f};
    bf16x8 At[4][2], B0[2][2], B1[2][2];
    const char* cA = (const char*)g.A + (size_t)cur.pm * tstep; const char* cB = (const char*)g.Bt + (size_t)cur.pn * tstep;
    S.a_ready(cur);
    if constexpr (SP2) {
        PG8_STAGE(PG8_SB(0, 0), cB, voffB); PG8_STAGE(PG8_SB(0, 1), cB + hstep, voffB); PG8_STAGE(PG8_SA(0, 0), cA, voffA); PG8_STAGE(PG8_SA(0, 1), cA + hstep, voffA);
        E.prep(cur, wr, wc, fr, fq);
        if (wr == 1) PG8_BAR;
        PG8_WAIT_V(2); PG8_BAR;
        PG8_STAGE(PG8_SB(1, 0), cB + kstep, voffB); PG8_STAGE(PG8_SA(1, 0), cA + kstep, voffA); PG8_STAGE(PG8_SB(1, 1), cB + hstep + kstep, voffB);
        PG8_WAIT_V(6); PG8_BAR;
    } else {
        PG8_STAGE(PG8_SB(0, 0), cB, voffB); PG8_STAGE(PG8_SA(0, 0), cA, voffA); PG8_STAGE(PG8_SB(0, 1), cB + hstep, voffB); PG8_STAGE(PG8_SA(0, 1), cA + hstep, voffA);
        if (wr == 1) PG8_BAR;
        PG8_WAIT_V(4); PG8_BAR;
        PG8_STAGE(PG8_SB(1, 0), cB + kstep, voffB); PG8_STAGE(PG8_SA(1, 0), cA + kstep, voffA); PG8_STAGE(PG8_SB(1, 1), cB + hstep + kstep, voffB);
        PG8_WAIT_V(6); PG8_BAR;
    }
    for (;;) {
        const bool has_next = S.next(ui + 1, nxt);
        const char* nA = has_next ? (const char*)g.A + (size_t)nxt.pm * tstep : cA; const char* nB = has_next ? (const char*)g.Bt + (size_t)nxt.pn * tstep : cB;
        for (int t = 0; t < nt; t += 2) {
            if constexpr (Epi::MIDK > 0) { if (t == Epi::MIDK) E.midk(acc, cur, wr, wc, fr, fq); }
            const bool last = (t == nt - 2);
            const char* a1 = cA + (size_t)(t + 1) * kstep;
            const char* a2 = last ? nA : cA + (size_t)(t + 2) * kstep; const char* b2 = last ? nB : cB + (size_t)(t + 2) * kstep;
            const char* a3 = a2 + kstep; const char* b3 = b2 + kstep;
            if (last && has_next) S.a_ready(nxt);
            if constexpr (SP2) {
            PG8_LDB(B0, 0, 0); PG8_LDB(B1, 0, 1); PG8_SCHED; PG8_LDA(At, 0, 0); PG8_STAGE(PG8_SA(1, 1), a1 + hstep, voffA);
            PG8_WAIT_V(8); PG8_WAIT_L(0); PG8_BAR; PG8_MMA(0, 0, At, B0); PG8_MMA(0, 1, At, B1); PG8_BAR; PG8_SCHED;
            PG8_LDA(At, 0, 1); PG8_STAGE(PG8_SB(0, 0), b2, voffB); PG8_STAGE(PG8_SB(0, 1), b2 + hstep, voffB); PG8_STAGE(PG8_SA(0, 0), a2, voffA);
            PG8_WAIT_V(8); PG8_WAIT_L(0); PG8_BAR; PG8_MMA(1, 0, At, B0); PG8_MMA(1, 1, At, B1); PG8_BAR; PG8_SCHED;
            PG8_LDB(B0, 1, 0); PG8_LDB(B1, 1, 1); PG8_SCHED; PG8_LDA(At, 1, 0); PG8_STAGE(PG8_SA(0, 1), a2 + hstep, voffA);
            PG8_WAIT_V(8); PG8_WAIT_L(0); PG8_BAR; PG8_MMA(0, 0, At, B0); PG8_MMA(0, 1, At, B1); PG8_BAR; PG8_SCHED;
            PG8_LDA(At, 1, 1); PG8_STAGE(PG8_SB(1, 0), b3, voffB); PG8_STAGE(PG8_SB(1, 1), b3 + hstep, voffB); PG8_STAGE(PG8_SA(1, 0), a3, voffA);
            PG8_WAIT_V(8); PG8_WAIT_L(0); PG8_BAR; PG8_MMA(1, 0, At, B0); PG8_MMA(1, 1, At, B1); PG8_BAR; PG8_SCHED;
            } else {
            PG8_LDB(B0, 0, 0); PG8_SCHED; PG8_LDA(At, 0, 0); PG8_STAGE(PG8_SA(1, 1), a1 + hstep, voffA);
            PG8_WAIT_L(8); PG8_BAR; PG8_WAIT_L(0); PG8_MMA(0, 0, At, B0); PG8_BAR; PG8_SCHED;
            PG8_LDB(B1, 0, 1); PG8_STAGE(PG8_SB(0, 0), b2, voffB);
            PG8_BAR; PG8_WAIT_L(0); PG8_MMA(0, 1, At, B1); PG8_BAR;
            PG8_LDA(At, 0, 1); PG8_STAGE(PG8_SA(0, 0), a2, voffA);
            PG8_BAR; PG8_WAIT_L(0); PG8_MMA(1, 0, At, B0); PG8_BAR; PG8_SCHED;
            PG8_STAGE(PG8_SB(0, 1), b2 + hstep, voffB);
            PG8_WAIT_V(6); PG8_BAR; PG8_MMA(1, 1, At, B1); PG8_BAR;
            PG8_LDB(B0, 1, 0); PG8_SCHED; PG8_LDA(At, 1, 0); PG8_STAGE(PG8_SA(0, 1), a2 + hstep, voffA);
            PG8_WAIT_L(8); PG8_BAR; PG8_WAIT_L(0); PG8_MMA(0, 0, At, B0); PG8_BAR; PG8_SCHED;
            PG8_LDB(B1, 1, 1); PG8_STAGE(PG8_SB(1, 0), b3, voffB);
            PG8_BAR; PG8_WAIT_L(0); PG8_MMA(0, 1, At, B1); PG8_BAR;
            PG8_LDA(At, 1, 1); PG8_STAGE(PG8_SA(1, 0), a3, voffA);
            PG8_BAR; PG8_WAIT_L(0); PG8_MMA(1, 0, At, B0); PG8_BAR; PG8_SCHED;
            PG8_STAGE(PG8_SB(1, 1), b3 + hstep, voffB);
            PG8_WAIT_V(6); PG8_BAR; PG8_MMA(1, 1, At, B1); PG8_BAR;
            }
        }
        if constexpr (ALIGN_EPI) { if (wr == 0) PG8_BAR; }
        if constexpr (!Epi::AFTER_DRAIN) { E(acc, cur, wr, wc, fr, fq); S.done(cur); }
        if (!has_next) break;
        E.prep(nxt, wr, wc, fr, fq);
#pragma unroll
        for (int a = 0; a < 2; ++a)
#pragma unroll
            for (int b = 0; b < 2; ++b)
#pragma unroll
                for (int m = 0; m < 4; ++m)
#pragma unroll
                    for (int n = 0; n < 2; ++n) acc[a][b][m][n] = (f32x4){0.f, 0.f, 0.f, 0.f};
        cur = nxt; cA = nA; cB = nB; ++ui;
        if constexpr (ALIGN_EPI) { if (wr == 1) PG8_BAR; }
    }
    PG8_WAIT_V(0);
    if constexpr (!ALIGN_EPI) { if (wr == 0) PG8_BAR; }
    PG8_BAR;
    if constexpr (Epi::AFTER_DRAIN) { E.fused(acc, cur, wr, wc, fr, fq, lds, wid, lane); S.done(cur); }
#undef PG8_SA
#undef PG8_SB
#undef PG8_STAGE
#undef PG8_LDA
#undef PG8_LDB
#undef PG8_MMA
#undef PG8_WAIT_V
#undef PG8_WAIT_L
#undef PG8_BAR
#undef PG8_SCHED
}
}

namespace att {
using bf16 = __hip_bfloat16;
constexpr int   D = 128, NW = 8, QBLK = 32, KVBLK = 64;
constexpr float SCALE = 0.088388347648318440f;
constexpr float THR = 8.f;
constexpr int SDEPTH = 1;
constexpr int LDQ = ATT_LDQ, LDK = ATT_LDK, LDO = ATT_LDO, LDG = ATT_LDG;
constexpr size_t SHM_V = KVBLK * D * 2, SHM_K = KVBLK * D * 2, SHM_ATTN = 2 * SHM_V + 2 * SHM_K + NW * 64 * 4;
using bf16x8 = __attribute__((ext_vector_type(8))) short;
using s16x4  = __attribute__((ext_vector_type(4))) short;
using f32x16 = __attribute__((ext_vector_type(16))) float;
using f32x8  = __attribute__((ext_vector_type(8))) float;
using u32x4  = __attribute__((ext_vector_type(4))) unsigned;
#define KSWZ(row, colB) ((row) * 256 + ((colB) ^ (((row) & 7) << 4)))
#define SBAR() __builtin_amdgcn_sched_barrier(0)
__device__ __forceinline__ int crow(int r, int hi) { return (r & 3) + 8 * (r >> 2) + 4 * hi; }
__device__ __forceinline__ unsigned cvtpk(float lo, float hi) {
  unsigned r; asm volatile("v_cvt_pk_bf16_f32 %0, %1, %2" : "=v"(r) : "v"(lo), "v"(hi)); return r;
}
template <typename TIn> struct Stage;
template <> struct Stage<bf16>  { using T = bf16x8;
  __device__ static __forceinline__ T ld8(const bf16* p) { return *reinterpret_cast<const bf16x8*>(p); }
  __device__ static __forceinline__ bf16x8 tobf(T x) { return x; } };
template <> struct Stage<float> { using T = f32x8;
  __device__ static __forceinline__ T ld8(const float* p) { return *reinterpret_cast<const f32x8*>(p); }
  __device__ static __forceinline__ bf16x8 tobf(T x) {
    u32x4 w = {cvtpk(x[0], x[1]), cvtpk(x[2], x[3]), cvtpk(x[4], x[5]), cvtpk(x[6], x[7])}; return *reinterpret_cast<bf16x8*>(&w); } };

__device__ __forceinline__ void partialSM(f32x16& p0, f32x16& p1, float& m_reg, float& mn, float& alpha) {
  constexpr float C = SCALE * 1.4426950408889634f;
  float pmax = p0[0]; for (int r = 1; r < 16; ++r) pmax = fmaxf(pmax, p0[r]); for (int r = 0; r < 16; ++r) pmax = fmaxf(pmax, p1[r]);
  { auto rr = __builtin_amdgcn_permlane32_swap(__float_as_uint(pmax), __float_as_uint(pmax), false, false);
    pmax = fmaxf(__uint_as_float(rr[0]), __uint_as_float(rr[1])); }
  if (__builtin_expect(__all(pmax - m_reg <= THR / SCALE), 1)) { mn = m_reg; alpha = 1.f; }
  else { mn = fmaxf(m_reg, pmax); alpha = __builtin_amdgcn_exp2f((m_reg - mn) * C); m_reg = mn; }
  float mnC = -mn * C;
  for (int r = 0; r < 16; ++r) p0[r] = fmaf(p0[r], C, mnC); for (int r = 0; r < 16; ++r) p1[r] = fmaf(p1[r], C, mnC);
  for (int r = 0; r < 16; ++r) p0[r] = __builtin_amdgcn_exp2f(p0[r]);
}
__device__ __forceinline__ void finishSM(f32x16& p0, f32x16& p1, float alpha, float& l_reg, bf16x8& pa0, bf16x8& pa1, bf16x8& pa2, bf16x8& pa3) {
  for (int r = 0; r < 16; ++r) p1[r] = __builtin_amdgcn_exp2f(p1[r]);
  float ps = 0; for (int r = 0; r < 16; ++r) ps += p0[r]; for (int r = 0; r < 16; ++r) ps += p1[r];
  { auto rr = __builtin_amdgcn_permlane32_swap(__float_as_uint(ps), __float_as_uint(ps), false, false);
    ps = __uint_as_float(rr[0]) + __uint_as_float(rr[1]); }
  l_reg = l_reg * alpha + ps;
#define PK4(P, BASE, OUT) do { unsigned a0 = cvtpk(P[BASE + 0], P[BASE + 1]), a1 = cvtpk(P[BASE + 2], P[BASE + 3]);   \
    unsigned b0 = cvtpk(P[BASE + 4], P[BASE + 5]), b1 = cvtpk(P[BASE + 6], P[BASE + 7]);                              \
    auto r0 = __builtin_amdgcn_permlane32_swap(a0, b0, false, false); auto r1 = __builtin_amdgcn_permlane32_swap(a1, b1, false, false); \
    u32x4 w = {r0[0], r1[0], r0[1], r1[1]}; OUT = *reinterpret_cast<bf16x8*>(&w); } while (0)
  PK4(p0, 0, pa0); PK4(p0, 8, pa1); PK4(p1, 0, pa2); PK4(p1, 8, pa3);
#undef PK4
}
__device__ __forceinline__ void qkt(f32x16& p0, f32x16& p1, const bf16* Ks, const bf16x8* qr, int r32, int hi) {
  p0 = f32x16{}; p1 = f32x16{};
  for (int d0 = 0; d0 < 8; ++d0) { int cb = (d0 * 16 + hi * 8) * 2;
    bf16x8 b0 = *reinterpret_cast<const bf16x8*>((const char*)Ks + KSWZ(r32, cb));
    bf16x8 b1 = *reinterpret_cast<const bf16x8*>((const char*)Ks + KSWZ(32 + r32, cb));
    p0 = __builtin_amdgcn_mfma_f32_32x32x16_bf16(b0, qr[d0], p0, 0, 0, 0);
    p1 = __builtin_amdgcn_mfma_f32_32x32x16_bf16(b1, qr[d0], p1, 0, 0, 0); }
}
__device__ __forceinline__ int v_st(int k, int c) { const int kk = (k & ~0xC) | ((k & 4) << 1) | ((k & 8) >> 1); return ((kk >> 3) * 4 + (c >> 5)) * 512 + ((kk & 7) * 32 + (c & 31)) * 2; }
__device__ __forceinline__ int v_rd_base(int lane) { return ((lane & 3) << 3) | (((lane >> 2) & 3) << 6) | (((lane >> 4) & 1) << 5) | (((lane >> 5) & 1) << 8); }
constexpr int v_rd_off(int d0, int ks, int half) { return d0 * 512 + ks * 4096 + half * 2048; }
template <int OFF> __device__ __forceinline__ s16x4 tr_read(int vb) {
  s16x4 r; asm volatile("ds_read_b64_tr_b16 %0, %1 offset:%2" : "=&v"(r) : "v"(vb), "i"(OFF) : "memory"); return r;
}
template <int D0> __device__ __forceinline__ void pv_one(f32x16& od, int vb, bf16x8 pa0, bf16x8 pa1, bf16x8 pa2, bf16x8 pa3) {
  const s16x4 l0 = tr_read<v_rd_off(D0, 0, 0)>(vb), h0 = tr_read<v_rd_off(D0, 0, 1)>(vb), l1 = tr_read<v_rd_off(D0, 1, 0)>(vb), h1 = tr_read<v_rd_off(D0, 1, 1)>(vb);
  const s16x4 l2 = tr_read<v_rd_off(D0, 2, 0)>(vb), h2 = tr_read<v_rd_off(D0, 2, 1)>(vb), l3 = tr_read<v_rd_off(D0, 3, 0)>(vb), h3 = tr_read<v_rd_off(D0, 3, 1)>(vb);
  asm volatile("s_waitcnt lgkmcnt(0)" ::: "memory"); SBAR();
#define PK(L, H) (bf16x8){L[0], L[1], L[2], L[3], H[0], H[1], H[2], H[3]}
  od = __builtin_amdgcn_mfma_f32_32x32x16_bf16(pa0, PK(l0, h0), od, 0, 0, 0);
  od = __builtin_amdgcn_mfma_f32_32x32x16_bf16(pa1, PK(l1, h1), od, 0, 0, 0);
  od = __builtin_amdgcn_mfma_f32_32x32x16_bf16(pa2, PK(l2, h2), od, 0, 0, 0);
  od = __builtin_amdgcn_mfma_f32_32x32x16_bf16(pa3, PK(l3, h3), od, 0, 0, 0);
#undef PK
}
__device__ __forceinline__ void pv_d0(f32x16* o, int vb, bf16x8 pa0, bf16x8 pa1, bf16x8 pa2, bf16x8 pa3) {
  pv_one<0>(o[0], vb, pa0, pa1, pa2, pa3); pv_one<1>(o[1], vb, pa0, pa1, pa2, pa3); pv_one<2>(o[2], vb, pa0, pa1, pa2, pa3); pv_one<3>(o[3], vb, pa0, pa1, pa2, pa3);
}

constexpr float THRL = THR * 1.4426950408889634f;
__device__ __forceinline__ void qkt2(f32x16& p0, f32x16& p1, const bf16* Ks, const bf16x8* qr, const f32x16& negm, int r32, int hi) {
  p0 = negm; p1 = negm;
  for (int d0 = 0; d0 < 8; ++d0) { int cb = (d0 * 16 + hi * 8) * 2;
    bf16x8 b0 = *reinterpret_cast<const bf16x8*>((const char*)Ks + KSWZ(r32, cb));
    bf16x8 b1 = *reinterpret_cast<const bf16x8*>((const char*)Ks + KSWZ(32 + r32, cb));
    p0 = __builtin_amdgcn_mfma_f32_32x32x16_bf16(b0, qr[d0], p0, 0, 0, 0);
    p1 = __builtin_amdgcn_mfma_f32_32x32x16_bf16(b1, qr[d0], p1, 0, 0, 0); }
}
template <bool FIRST> __device__ __forceinline__ void partialSM2(f32x16& p0, f32x16& p1, float& m_ref, f32x16& negm, float& alpha) {
  float pmax = p0[0]; for (int r = 1; r < 16; ++r) pmax = fmaxf(pmax, p0[r]); for (int r = 0; r < 16; ++r) pmax = fmaxf(pmax, p1[r]);
  { auto rr = __builtin_amdgcn_permlane32_swap(__float_as_uint(pmax), __float_as_uint(pmax), false, false);
    pmax = fmaxf(__uint_as_float(rr[0]), __uint_as_float(rr[1])); }
  alpha = 1.f;
  if (FIRST || __builtin_expect(!__all(pmax <= THRL), 0)) {
    const float dl = FIRST ? pmax : fmaxf(pmax, 0.f);
    m_ref += dl;
    for (int r = 0; r < 16; ++r) { p0[r] -= dl; p1[r] -= dl; }
    for (int r = 0; r < 16; ++r) negm[r] = -m_ref;
    asm volatile("" : "+v"(negm));
    if (!FIRST) alpha = __builtin_amdgcn_exp2f(-dl);
  }
}

__device__ __forceinline__ void glds16s(const void* sbase, unsigned voff, unsigned lds_dst) { unsigned keep;
  asm volatile("s_nop 4\n\ts_mov_b32 %0, m0\n\ts_mov_b32 m0, %3\n\ts_nop 0\n\tglobal_load_lds_dwordx4 %1, %2\n\ts_mov_b32 m0, %0" : "=&s"(keep) : "v"(voff), "s"(sbase), "s"(lds_dst) : "memory"); }
__device__ __forceinline__ const char* uni_ptr(const void* p) { const unsigned long long v = (unsigned long long)p;
  const unsigned lo = __builtin_amdgcn_readfirstlane((unsigned)v), hi = __builtin_amdgcn_readfirstlane((unsigned)(v >> 32)); return (const char*)(((unsigned long long)hi << 32) | lo); }

#define TRD8(D0, S) S##l0 = tr_read<v_rd_off(D0, 0, 0)>(vb), S##h0 = tr_read<v_rd_off(D0, 0, 1)>(vb), S##l1 = tr_read<v_rd_off(D0, 1, 0)>(vb), S##h1 = tr_read<v_rd_off(D0, 1, 1)>(vb), \
                    S##l2 = tr_read<v_rd_off(D0, 2, 0)>(vb), S##h2 = tr_read<v_rd_off(D0, 2, 1)>(vb), S##l3 = tr_read<v_rd_off(D0, 3, 0)>(vb), S##h3 = tr_read<v_rd_off(D0, 3, 1)>(vb)
#define PKV(L, H) (bf16x8){L[0], L[1], L[2], L[3], H[0], H[1], H[2], H[3]}
#define MM4(OD, S) do { OD = __builtin_amdgcn_mfma_f32_32x32x16_bf16(pa0, PKV(S##l0, S##h0), OD, 0, 0, 0); OD = __builtin_amdgcn_mfma_f32_32x32x16_bf16(pa1, PKV(S##l1, S##h1), OD, 0, 0, 0); \
                        OD = __builtin_amdgcn_mfma_f32_32x32x16_bf16(pa2, PKV(S##l2, S##h2), OD, 0, 0, 0); OD = __builtin_amdgcn_mfma_f32_32x32x16_bf16(pa3, PKV(S##l3, S##h3), OD, 0, 0, 0); } while (0)
__device__ __forceinline__ void pv_pipe(f32x16* o, int vb, bf16x8 pa0, bf16x8 pa1, bf16x8 pa2, bf16x8 pa3) {
  s16x4 al0, ah0, al1, ah1, al2, ah2, al3, ah3, bl0, bh0, bl1, bh1, bl2, bh2, bl3, bh3;
  TRD8(0, a);
  TRD8(1, b); asm volatile("s_waitcnt lgkmcnt(8)" ::: "memory"); SBAR(); MM4(o[0], a); SBAR();
  TRD8(2, a); asm volatile("s_waitcnt lgkmcnt(8)" ::: "memory"); SBAR(); MM4(o[1], b); SBAR();
  TRD8(3, b); asm volatile("s_waitcnt lgkmcnt(8)" ::: "memory"); SBAR(); MM4(o[2], a); SBAR();
  asm volatile("s_waitcnt lgkmcnt(0)" ::: "memory"); SBAR(); MM4(o[3], b);
}
#undef TRD8
#undef PKV
#undef MM4

#define VPRE_DECL s16x4 eal0, eah0, eal1, eah1, eal2, eah2, eal3, eah3, ebl0, ebh0, ebl1, ebh1, ebl2, ebh2, ebl3, ebh3
#define VTRD8(D0, S, VB) S##l0 = tr_read<v_rd_off(D0, 0, 0)>(VB), S##h0 = tr_read<v_rd_off(D0, 0, 1)>(VB), S##l1 = tr_read<v_rd_off(D0, 1, 0)>(VB), S##h1 = tr_read<v_rd_off(D0, 1, 1)>(VB), \
                         S##l2 = tr_read<v_rd_off(D0, 2, 0)>(VB), S##h2 = tr_read<v_rd_off(D0, 2, 1)>(VB), S##l3 = tr_read<v_rd_off(D0, 3, 0)>(VB), S##h3 = tr_read<v_rd_off(D0, 3, 1)>(VB)
#define VPKV(L, H) (bf16x8){L[0], L[1], L[2], L[3], H[0], H[1], H[2], H[3]}
#define VMM4(OD, S) do { OD = __builtin_amdgcn_mfma_f32_32x32x16_bf16(pa0, VPKV(S##l0, S##h0), OD, 0, 0, 0); OD = __builtin_amdgcn_mfma_f32_32x32x16_bf16(pa1, VPKV(S##l1, S##h1), OD, 0, 0, 0); \
                         OD = __builtin_amdgcn_mfma_f32_32x32x16_bf16(pa2, VPKV(S##l2, S##h2), OD, 0, 0, 0); OD = __builtin_amdgcn_mfma_f32_32x32x16_bf16(pa3, VPKV(S##l3, S##h3), OD, 0, 0, 0); } while (0)
#define VPRE(VB) do { VTRD8(0, ea, VB); } while (0)
#define VPOST(O, VB) do { VTRD8(1, eb, VB); asm volatile("s_waitcnt lgkmcnt(8)" ::: "memory"); SBAR(); VMM4(O[0], ea); SBAR(); \
    VTRD8(2, ea, VB); asm volatile("s_waitcnt lgkmcnt(8)" ::: "memory"); SBAR(); VMM4(O[1], eb); SBAR(); \
    VTRD8(3, eb, VB); asm volatile("s_waitcnt lgkmcnt(8)" ::: "memory"); SBAR(); VMM4(O[2], ea); SBAR(); \
    asm volatile("s_waitcnt lgkmcnt(0)" ::: "memory"); SBAR(); VMM4(O[3], eb); } while (0)
__device__ __forceinline__ void finishSM2(f32x16& p0, f32x16& p1, float alpha, float& l_reg, bf16x8& pa0, bf16x8& pa1, bf16x8& pa2, bf16x8& pa3) {
  for (int r = 0; r < 16; ++r) p0[r] = __builtin_amdgcn_exp2f(p0[r]);
  for (int r = 0; r < 16; ++r) p1[r] = __builtin_amdgcn_exp2f(p1[r]);
  float ps = 0; for (int r = 0; r < 16; ++r) ps += p0[r]; for (int r = 0; r < 16; ++r) ps += p1[r];
  { auto rr = __builtin_amdgcn_permlane32_swap(__float_as_uint(ps), __float_as_uint(ps), false, false);
    ps = __uint_as_float(rr[0]) + __uint_as_float(rr[1]); }
  l_reg = l_reg * alpha + ps;
#define PK8(P, BASE, OUT) do { u32x4 w = {cvtpk(P[BASE + 0], P[BASE + 1]), cvtpk(P[BASE + 2], P[BASE + 3]), cvtpk(P[BASE + 4], P[BASE + 5]), cvtpk(P[BASE + 6], P[BASE + 7])}; OUT = *reinterpret_cast<bf16x8*>(&w); } while (0)
  PK8(p0, 0, pa0); PK8(p0, 8, pa1); PK8(p1, 0, pa2); PK8(p1, 8, pa3);
#undef PK8
}

__device__ __forceinline__ void finishFX(f32x16& p0, f32x16& p1, float& l_part, bf16x8& pa0, bf16x8& pa1, bf16x8& pa2, bf16x8& pa3) {
  for (int r = 0; r < 16; ++r) p0[r] = __builtin_amdgcn_exp2f(p0[r]);
  for (int r = 0; r < 16; ++r) p1[r] = __builtin_amdgcn_exp2f(p1[r]);
  float ps = 0; for (int r = 0; r < 16; ++r) ps += p0[r]; for (int r = 0; r < 16; ++r) ps += p1[r];
  l_part += ps;
#define PK8(P, BASE, OUT) do { u32x4 w = {cvtpk(P[BASE + 0], P[BASE + 1]), cvtpk(P[BASE + 2], P[BASE + 3]), cvtpk(P[BASE + 4], P[BASE + 5]), cvtpk(P[BASE + 6], P[BASE + 7])}; OUT = *reinterpret_cast<bf16x8*>(&w); } while (0)
  PK8(p0, 0, pa0); PK8(p0, 8, pa1); PK8(p1, 0, pa2); PK8(p1, 8, pa3);
#undef PK8
}

template <typename TQ, bool FIXED>
__device__ __forceinline__ void attn_dense_body(const TQ* __restrict__ Qb, const bf16* __restrict__ Kh_, const bf16* __restrict__ Vh_,
                                                bf16* __restrict__ Gm, float* __restrict__ ssqa, int seq, char* lds, float refB) {
  using SQ = Stage<TQ>;
  constexpr int SLOT = (int)(SHM_V + SHM_K);
  const int tid = ltid(), wid = tid >> 6, lane = tid & 63, r32 = lane & 31, hi = lane >> 5;
  const char* Kh = uni_ptr(Kh_); const char* Vh = uni_ptr(Vh_);
  float* ws = (float*)(lds + (FIXED ? 4 : 3) * SLOT) + wid * 64; float* li_l = ws; float* al_l = ws + 32;
  float m_reg = FIXED ? refB : 0.f, l_reg = 0; f32x16 negm; for (int r = 0; r < 16; ++r) negm[r] = -m_reg; asm volatile("" : "+v"(negm));
  f32x16 o[4] = {}; bf16x8 qr[8];
  const TQ* Qw = Qb + (long)(wid * QBLK + r32) * LDQ + hi * 8;
#pragma unroll
  for (int d0 = 0; d0 < 8; ++d0) qr[d0] = SQ::tobf(SQ::ld8(Qw + d0 * 16));
  const unsigned ldsb = (unsigned)(uintptr_t)lds; const int vb0 = (int)ldsb + v_rd_base(lane);
  unsigned koff[2], voff[2];
#pragma unroll
  for (int i = 0; i < 2; ++i) { const int p = 2 * wid + i, row = 4 * p + (lane >> 4), c = (lane & 15) ^ (row & 7); koff[i] = (unsigned)(row * LDK + c * 8) * 2u;
    const int l5 = lane & 31, kk = (p >> 1) * 8 + (l5 >> 2), k = kk  , cc = (2 * (p & 1) + (lane >> 5)) * 32 + (lane & 3) * 8; voff[i] = (unsigned)(k * LDK + cc) * 2u; }
#define DMA(T, off) do { const char* kb_ = Kh + (size_t)(T) * (KVBLK * LDK * 2); const char* vb_ = Vh + (size_t)(T) * (KVBLK * LDK * 2); \
    const unsigned d_ = (unsigned)__builtin_amdgcn_readfirstlane(ldsb + (unsigned)(off) + (unsigned)wid * 2048u); \
    glds16s(vb_, voff[0], d_); glds16s(vb_, voff[1], d_ + 1024u); glds16s(kb_, koff[0], d_ + (unsigned)SHM_V); glds16s(kb_, koff[1], d_ + (unsigned)SHM_V + 1024u); } while (0)
#define WAIT_BAR() asm volatile("s_waitcnt vmcnt(0) lgkmcnt(0)\n\ts_barrier" ::: "memory")
#define RESC(a) do { if (__any((a) < 1.f)) { if (hi == 0) al_l[r32] = (a); asm volatile("s_waitcnt lgkmcnt(0)" ::: "memory"); \
    for (int d = 0; d < 4; ++d) for (int r = 0; r < 16; ++r) o[d][r] *= al_l[crow(r, hi)]; } } while (0)
#define KPTR(off) ((const bf16*)(lds + (off) + SHM_V))
#define ROT() do { const int t_ = rP; rP = rK; rK = rN; rN = t_; } while (0)
#define STEP(X0, X1, XA, Y0, Y1, YA, t, WR) do { \
    if (WR) { DMA((t) + 1, rN); } \
    SBAR(); qkt2(X0, X1, KPTR(rK), qr, negm, r32, hi); \
    if constexpr (FIXED) finishFX(Y0, Y1, l_reg, pa0, pa1, pa2, pa3); else finishSM2(Y0, Y1, YA, l_reg, pa0, pa1, pa2, pa3); SBAR(); \
    pv_pipe(o, vb0 + rP, pa0, pa1, pa2, pa3); if constexpr (!FIXED) { partialSM2<false>(X0, X1, m_reg, negm, XA); RESC(XA); } \
    WAIT_BAR(); ROT(); } while (0)
  f32x16 pA0, pA1, pB0, pB1; float alA = 1.f, alB = 1.f; bf16x8 pa0, pa1, pa2, pa3; const int NT = seq / KVBLK;
  int rP = 2 * SLOT, rK = 0, rN = SLOT;
  VPRE_DECL;
  if constexpr (FIXED) {
#define SL(t_) ((((t_)) & 3) * SLOT)
#define PVD(T, VB, WR) do { const char* kb_ = Kh + (size_t)(T) * (KVBLK * LDK * 2); const char* vb_ = Vh + (size_t)(T) * (KVBLK * LDK * 2); \
    const unsigned d_ = (unsigned)__builtin_amdgcn_readfirstlane(ldsb + (unsigned)SL(T) + (unsigned)wid * 2048u); \
    VTRD8(0, ea, VB); VTRD8(1, eb, VB); asm volatile("s_waitcnt lgkmcnt(8)" ::: "memory"); SBAR(); VMM4(o[0], ea); if (WR) glds16s(vb_, voff[0], d_); SBAR(); \
    VTRD8(2, ea, VB); asm volatile("s_waitcnt lgkmcnt(8)" ::: "memory"); SBAR(); VMM4(o[1], eb); if (WR) glds16s(vb_, voff[1], d_ + 1024u); SBAR(); \
    VTRD8(3, eb, VB); asm volatile("s_waitcnt lgkmcnt(8)" ::: "memory"); SBAR(); VMM4(o[2], ea); if (WR) glds16s(kb_, koff[0], d_ + (unsigned)SHM_V); SBAR(); \
    asm volatile("s_waitcnt lgkmcnt(0)" ::: "memory"); SBAR(); VMM4(o[3], eb); if (WR) glds16s(kb_, koff[1], d_ + (unsigned)SHM_V + 1024u); } while (0)
#define STEPF(X0, X1, Y0, Y1, t_, WR) do { \
    SBAR(); qkt2(X0, X1, KPTR(SL(t_)), qr, negm, r32, hi); finishFX(Y0, Y1, l_reg, pa0, pa1, pa2, pa3); SBAR(); \
    PVD((t_) + 2, vb0 + SL((t_) - 1), WR); \
    if (WR) asm volatile("s_waitcnt vmcnt(4) lgkmcnt(0)\n\ts_barrier" ::: "memory"); else WAIT_BAR(); } while (0)
    DMA(0, 0); DMA(1, SLOT);
    asm volatile("s_waitcnt vmcnt(4) lgkmcnt(0)\n\ts_barrier" ::: "memory");
    qkt2(pA0, pA1, KPTR(0), qr, negm, r32, hi);
    DMA(2, 2 * SLOT);
    asm volatile("s_waitcnt vmcnt(4) lgkmcnt(0)\n\ts_barrier" ::: "memory");
    int t = 1;
    for (; t + 1 <= NT - 4; t += 2) { STEPF(pB0, pB1, pA0, pA1, t, true); STEPF(pA0, pA1, pB0, pB1, t + 1, true); }
    STEPF(pB0, pB1, pA0, pA1, NT - 3, true);
    STEPF(pA0, pA1, pB0, pB1, NT - 2, false);
    STEPF(pB0, pB1, pA0, pA1, NT - 1, false);
    rP = SL(NT - 1); rK = SL(NT); rN = SL(NT + 1);
#undef STEPF
#undef PVD
#undef SL
  } else {
  DMA(0, 0); DMA(1, rN);
  asm volatile("s_waitcnt vmcnt(4) lgkmcnt(0)\n\ts_barrier" ::: "memory");
  qkt2(pA0, pA1, KPTR(rK), qr, negm, r32, hi); if constexpr (!FIXED) partialSM2<true>(pA0, pA1, m_reg, negm, alA);
  WAIT_BAR(); ROT();
  int t = 1;
  for (; t + 1 <= NT - 2; t += 2) {
    STEP(pB0, pB1, alB, pA0, pA1, alA, t, true);
    STEP(pA0, pA1, alA, pB0, pB1, alB, t + 1, true);
  }
  STEP(pB0, pB1, alB, pA0, pA1, alA, NT - 1, false);
  }
  bf16* Gw = Gm + (long)(wid * QBLK) * LDG;
  u32x4 gvv[8];
#pragma unroll
  for (int i = 0; i < 8; ++i) gvv[i] = *(const u32x4*)(Gw + (long)(i * 4 + (lane >> 4)) * LDG + (lane & 15) * 8);
  if constexpr (FIXED) { finishFX(pB0, pB1, l_reg, pa0, pa1, pa2, pa3); auto rr = __builtin_amdgcn_permlane32_swap(__float_as_uint(l_reg), __float_as_uint(l_reg), false, false); l_reg = __uint_as_float(rr[0]) + __uint_as_float(rr[1]); }
  else finishSM2(pB0, pB1, alB, l_reg, pa0, pa1, pa2, pa3);
  SBAR();
  pv_pipe(o, vb0 + rP, pa0, pa1, pa2, pa3);
  if (hi == 0) li_l[r32] = l_reg; asm volatile("s_waitcnt lgkmcnt(0)" ::: "memory");
  float rli[16];
#pragma unroll
  for (int r = 0; r < 16; ++r) rli[r] = __builtin_amdgcn_rcpf(li_l[crow(r, hi)]);
  unsigned short* stg = (unsigned short*)(lds + (wid < 4 ? rK : rN) + (wid & 3) * 8192);
#pragma unroll
  for (int r = 0; r < 16; ++r) { const int orow = crow(r, hi);
#pragma unroll
    for (int d0 = 0; d0 < 4; ++d0) { const bf16 hv = __float2bfloat16(o[d0][r] * rli[r]); stg[orow * 128 + d0 * 32 + r32] = __builtin_bit_cast(unsigned short, hv); } }
  asm volatile("s_waitcnt lgkmcnt(0)" ::: "memory");
  float* sw = ssqa + (long)(wid * QBLK) * 8;
#pragma unroll
  for (int i = 0; i < 8; ++i) { const int row = i * 4 + (lane >> 4), ch = lane & 15;
    const u32x4 ov = *(const u32x4*)(stg + row * 128 + ch * 8); u32x4* gp = (u32x4*)(Gw + (long)row * LDG + ch * 8); const u32x4 gv = gvv[i];
    float s = 0.f; u32x4 w;
#pragma unroll
    for (int k = 0; k < 4; ++k) { const float o0 = __uint_as_float(ov[k] << 16), o1 = __uint_as_float(ov[k] & 0xffff0000u), g0 = __uint_as_float(gv[k] << 16), g1 = __uint_as_float(gv[k] & 0xffff0000u);
      s += o0 * o0 + o1 * o1; w[k] = cvtpk(o0 * g0, o1 * g1); }
    *gp = w;
    s += __shfl_xor(s, 1); s += __shfl_xor(s, 2); s += __shfl_xor(s, 4); s += __shfl_xor(s, 8);
    if (ch == 0) sw[row * 8] = s; }
#undef DMA
#undef WAIT_BAR
#undef RESC
#undef KPTR
#undef ROT
#undef STEP
}

#undef KSWZ
#undef SBAR
}

#define GAS __attribute__((address_space(1)))
#define LAS __attribute__((address_space(3)))
typedef unsigned short bf16;
typedef unsigned v4u __attribute__((ext_vector_type(4)));
typedef unsigned v2u __attribute__((ext_vector_type(2)));
typedef float f32x4 __attribute__((ext_vector_type(4)));
typedef float f32x2 __attribute__((ext_vector_type(2)));
__device__ __forceinline__ unsigned f2bf(float f) { unsigned u = __builtin_bit_cast(unsigned, f); return (u + 0x7fffu + ((u >> 16) & 1u)) >> 16; }
__device__ __forceinline__ unsigned pk2(float lo, float hi) { return f2bf(lo) | (f2bf(hi) << 16); }
__device__ __forceinline__ float bflo(unsigned u) { return __uint_as_float(u << 16); }
__device__ __forceinline__ float bfhi(unsigned u) { return __uint_as_float(u & 0xffff0000u); }
__device__ __forceinline__ float bf2f(bf16 h) { return __uint_as_float((unsigned)h << 16); }
__device__ __forceinline__ float wave_sum(float v) {
#pragma unroll
    for (int o = 1; o < 64; o <<= 1) v += __shfl_xor(v, o);
    return v;
}
__device__ __forceinline__ float silu_f(float g) { return g * __builtin_amdgcn_rcpf(1.f + __expf(-g)); }
__device__ __forceinline__ float gelu_f(float v) { return 0.5f * v * (1.f + erff(v * 0.70710678118654752f)); }
__device__ __forceinline__ void unpack8(const v4u& p, float (&f)[8]) {
    f[0] = bflo(p.x); f[1] = bfhi(p.x); f[2] = bflo(p.y); f[3] = bfhi(p.y); f[4] = bflo(p.z); f[5] = bfhi(p.z); f[6] = bflo(p.w); f[7] = bfhi(p.w);
}
__device__ __forceinline__ v4u pack8(const float (&f)[8]) { v4u o; o.x = pk2(f[0], f[1]); o.y = pk2(f[2], f[3]); o.z = pk2(f[4], f[5]); o.w = pk2(f[6], f[7]); return o; }

#define RLX_AGENT __ATOMIC_RELAXED, __HIP_MEMORY_SCOPE_AGENT
#define XB_TMO      128
#define XB_XCNT(j)  (256  + 64 * (j))
#define XB_XSUB(j)  (1280 + 64 * (j))
#define XB_XGEN(j)  (2304 + 64 * (j))
#define XB_TOP      3328
#define XB_TOPGEN   3392
#define XCD_BAR_WORDS 3456
#define XB_SPIN_CAP (1u << 18)

__device__ __forceinline__ unsigned xb_ld(unsigned* p)              { return __hip_atomic_load(p, __ATOMIC_RELAXED, __HIP_MEMORY_SCOPE_AGENT); }
__device__ __forceinline__ unsigned xb_add(unsigned* p, unsigned v) { return __hip_atomic_fetch_add(p, v, __ATOMIC_RELAXED, __HIP_MEMORY_SCOPE_AGENT); }
__device__ __forceinline__ unsigned xb_xcc_id() { return (unsigned)__builtin_amdgcn_s_getreg((3 << 11) | 20) & 0xFu; }
#define XB_SPIN(cond, bar) do { unsigned _sp = 0; while (cond) { __builtin_amdgcn_s_sleep(1); \
    if ((++_sp & 255u) == 0u) { if (xb_ld(&(bar)[XB_TMO])) break; if (_sp > XB_SPIN_CAP) { atomicAdd(&(bar)[XB_TMO], 1u); break; } } } } while (0)

struct XcdBarrier {
    unsigned* bar; unsigned x;
    volatile LAS unsigned* st;
};

__device__ __forceinline__ XcdBarrier xcd_barrier_post(unsigned* bar, volatile LAS unsigned* st) {
    XcdBarrier b; b.bar = bar; b.x = xb_xcc_id(); b.st = st;
    if (threadIdx.x == 0) (void)xb_add(&bar[XB_XCNT(b.x)], 1u);
    return b;
}
__device__ __forceinline__ void xcd_barrier_complete(unsigned* bar, unsigned x, unsigned& nloc, unsigned& nx) {
    const unsigned G = gridDim.x * gridDim.y * gridDim.z;
    unsigned sum, cnt, mine, sp = 0u;
    for (;;) {
        sum = 0u; cnt = 0u; mine = 0u;
#pragma unroll
        for (unsigned j = 0; j < 16; ++j) { const unsigned c = xb_ld(&bar[XB_XCNT(j)]); sum += c; cnt += (c > 0u) ? 1u : 0u; mine = (j == x) ? c : mine; }
        if (sum == G) break;
        __builtin_amdgcn_s_sleep(1);
        if ((++sp & 255u) == 0u) { if (xb_ld(&bar[XB_TMO])) break; if (sp > XB_SPIN_CAP) { atomicAdd(&bar[XB_TMO], 1u); break; } }
    }
    nloc = mine > 0u ? mine : 1u; nx = cnt > 0u ? cnt : 1u;
}

__device__ __forceinline__ void xcd_barrier(const XcdBarrier& b) {
    asm volatile("s_waitcnt vmcnt(0)" ::: "memory");
    __syncthreads();
    if (threadIdx.x == 0) {
        unsigned* bar = b.bar;
        __builtin_amdgcn_s_waitcnt(0);
        unsigned nloc = b.st[0], nx = b.st[1];
        if (nloc == 0u) { xcd_barrier_complete(bar, b.x, nloc, nx); b.st[0] = nloc; b.st[1] = nx; }
        const unsigned old = xb_add(&bar[XB_XSUB(b.x)], 1u);
        const unsigned gen = old / nloc;
        if (old + 1u == (gen + 1u) * nloc) {
            __builtin_amdgcn_fence(__ATOMIC_RELEASE, "agent");
            asm volatile("s_waitcnt vmcnt(0)" ::: "memory");
            const unsigned og = xb_add(&bar[XB_TOP], 1u);
            const unsigned tg = og / nx;
            if (og + 1u == (tg + 1u) * nx) xb_add(&bar[XB_TOPGEN], 1u);
            else XB_SPIN(xb_ld(&bar[XB_TOPGEN]) == tg, bar);
            __builtin_amdgcn_fence(__ATOMIC_ACQUIRE, "agent");
            xb_add(&bar[XB_XGEN(b.x)], 1u);
            asm volatile("s_waitcnt vmcnt(0)" ::: "memory");
        } else {
            XB_SPIN(xb_ld(&bar[XB_XGEN(b.x)]) == gen, bar);
            __builtin_amdgcn_fence(__ATOMIC_ACQUIRE, "agent");
            asm volatile("s_waitcnt vmcnt(0)" ::: "memory");
        }
    }
    __syncthreads();
}

struct Frame {
    LAS unsigned char* lds;
    int tid, lane, wave;
    int vcu, G;
    const float *x, *norm_w, *w_in, *q_norm_w, *k_norm_w, *conv_w, *sgu_norm_w, *sgu_w, *sgu_b, *branch_norm_w, *w_out, *final_norm_w;
    float* out;
    bf16 *Win_t, *Wout_t, *XB, *Q, *K, *V, *MIX, *H, *CB, *U, *VN;
    float *SSQP, *SSQA;
    f32x2* TAB;
    bf16* WSB;
};

__host__ __device__ __forceinline__ int orig_col(int nn) {
    const int tile = nn >> 8, p256 = nn & 255, bj = p256 >> 7, pos = p256 & 127, wc = pos >> 5, fq = (pos >> 3) & 3, n = (pos >> 2) & 1, i = pos & 3;
    const int d = (wc >> 1) * 64 + n * 32 + (wc & 1) * 16 + fq * 4 + i;
    if (tile < 4) return C_Q + (tile * 2 + bj) * HD + d;
    if (tile == 4) return C_K + bj * HD + d;
    if (tile == 5) return C_V + p256;
    if (tile < 10) return C_GA + (tile - 6) * 256 + p256;
    if (tile < 14) return (n ? C_CC : C_CIN) + (tile - 10) * 128 + bj * 64 + wc * 16 + fq * 4 + i;
    if (tile < 16) return C_CB + (tile - 14) * 256 + p256;
    if (tile < 18) return C_GC + (tile - 16) * 256 + p256;
    if (tile < 20) return C_SU + (tile - 18) * 256 + p256;
    if (tile < 22) return C_SV + (tile - 20) * 256 + p256;
    return C_GS + (tile - 22) * 256 + p256;
}

struct WItem { const float* src; size_t n; const float* rs; bf16* dst; };
__device__ __forceinline__ WItem witem_make(const float* W, const float* rowscale, int N, bf16* WT, int item, int lane, bool in_proj) {
    const int nblk = N / 32, kb = item / nblk, nb = item % nblk, k0 = 64 * kb, n0 = 32 * nb, j4 = (lane & 7) * 4, oc = in_proj ? orig_col(n0 + j4) : n0 + j4;
    WItem w; w.src = W + (size_t)(k0 + (lane >> 3)) * N + oc; w.n = (size_t)N; w.rs = rowscale ? rowscale + k0 : nullptr; w.dst = WT + (size_t)n0 * LDK2 + k0; return w;
}
__device__ __forceinline__ WItem witem_of(Frame& F, int which, int it) {
    if (which == 0) return witem_make(F.w_in, F.norm_w, IN_W, F.Win_t, it, F.lane, true);
    constexpr int I_IN_ = (DM / 64) * (IN_W / 32), I_OUT_ = (MIX_W / 64) * (DM / 32);
    if (it < I_IN_) return witem_make(F.w_in + (size_t)DM * IN_W, F.norm_w + DM, IN_W, F.Win_t + (size_t)IN_W * LDK2, it, F.lane, true);
    const int r = it - I_IN_, l = r / I_OUT_;
    return witem_make(F.w_out + (size_t)l * MIX_W * DM, nullptr, DM, F.Wout_t + (size_t)l * DM * LDK2, r - l * I_OUT_, F.lane, false);
}
__device__ __forceinline__ void witem_request(const WItem& w, f32x4 (&v)[8]) {
#pragma unroll
    for (int i = 0; i < 8; ++i) v[i] = *(const f32x4*)(w.src + (size_t)(8 * i) * w.n);
}
__device__ __forceinline__ void witem_finish(const WItem& w, const f32x4 (&v)[8], LAS float* scr, int lane) {
    const int j4 = (lane & 7) * 4, c = lane & 7;
    float rsv[8];
    if (w.rs) { const f32x4 a = *(const f32x4*)(w.rs + 8 * c), b = *(const f32x4*)(w.rs + 8 * c + 4); rsv[0] = a.x; rsv[1] = a.y; rsv[2] = a.z; rsv[3] = a.w; rsv[4] = b.x; rsv[5] = b.y; rsv[6] = b.z; rsv[7] = b.w; }
    else {
#pragma unroll
        for (int j = 0; j < 8; ++j) rsv[j] = 1.f; }
#pragma unroll
    for (int i = 0; i < 8; ++i) { LAS float* d = scr + (8 * i + (lane >> 3)) * 33 + j4; d[0] = v[i].x; d[1] = v[i].y; d[2] = v[i].z; d[3] = v[i].w; }
    asm volatile("s_waitcnt lgkmcnt(0)" ::: "memory");
#pragma unroll
    for (int j = 0; j < 4; ++j) { const int n = (lane >> 3) + 8 * j; const LAS float* s = scr + (8 * c) * 33 + n;
        v4u o; o.x = pk2(s[0 * 33] * rsv[0], s[1 * 33] * rsv[1]); o.y = pk2(s[2 * 33] * rsv[2], s[3 * 33] * rsv[3]); o.z = pk2(s[4 * 33] * rsv[4], s[5 * 33] * rsv[5]); o.w = pk2(s[6 * 33] * rsv[6], s[7 * 33] * rsv[7]);
        *(GAS v4u*)(w.dst + (size_t)n * LDK2 + 8 * c) = o; }
    asm volatile("s_waitcnt lgkmcnt(0)" ::: "memory");
}
__device__ __forceinline__ void rows4_to_bf16_ssq(int lane, const float* x, bf16* xb, float* ssqp, int m, int ms, int nr) {
    f32x4 v[4][8];
#pragma unroll
    for (int r = 0; r < 4; ++r) if (r < nr) { const f32x4* xr = (const f32x4*)(x + (size_t)(m + r * ms) * DM) + lane;
#pragma unroll
        for (int j = 0; j < 8; ++j) v[r][j] = xr[64 * j]; }
#pragma unroll
    for (int r = 0; r < 4; ++r) if (r < nr) { float s = 0.f;
#pragma unroll
        for (int j = 0; j < 8; ++j) s += (v[r][j].x * v[r][j].x + v[r][j].y * v[r][j].y) + (v[r][j].z * v[r][j].z + v[r][j].w * v[r][j].w);
        s = wave_sum(s);
        v2u* o8 = (v2u*)(xb + (size_t)(m + r * ms) * LDK2) + lane;
#pragma unroll
        for (int j = 0; j < 8; ++j) { v2u o; o.x = pk2(v[r][j].x, v[r][j].y); o.y = pk2(v[r][j].z, v[r][j].w); o8[64 * j] = o; }
        if (lane < 2) ((f32x4*)(ssqp + (size_t)(m + r * ms) * 8))[lane] = (f32x4){lane == 0 ? s : 0.f, 0.f, 0.f, 0.f}; }
}
__device__ __forceinline__ float rstd_from_ssq8(const float* ssq8) {
    const f32x4 a = ((const f32x4*)ssq8)[0], b = ((const f32x4*)ssq8)[1];
    return 1.f / sqrtf((((a.x + a.y) + (a.z + a.w)) + ((b.x + b.y) + (b.z + b.w))) * (1.f / DM) + EPS);
}

constexpr int I_IN = (DM / 64) * (IN_W / 32), I_OUT = (MIX_W / 64) * (DM / 32);
__device__ __forceinline__ void convert_weights(Frame& F, int which) {
    LAS float* scr = (LAS float*)(F.lds + F.wave * 16384);
    const int gw = F.vcu * NWAVES + F.wave, NGW = F.G * NWAVES, NIT = which == 0 ? I_IN : I_IN + 2 * I_OUT;
    f32x4 va[8], vb[8]; WItem wa, wb;
    int it = gw;
    if (it < NIT) { wa = witem_of(F, which, it); witem_request(wa, va); }
    while (it < NIT) {
        int nx = it + NGW;
        if (nx < NIT) { wb = witem_of(F, which, nx); witem_request(wb, vb); }
        witem_finish(wa, va, scr, F.lane);
        it = nx; if (it >= NIT) break;
        nx = it + NGW;
        if (nx < NIT) { wa = witem_of(F, which, nx); witem_request(wa, va); }
        witem_finish(wb, vb, scr, F.lane);
        it = nx;
    }
}
__device__ __forceinline__ void phase_prologue(Frame& F) {
    const int gw = F.vcu * NWAVES + F.wave, NGW = F.G * NWAVES;
    convert_weights(F, 0);
    { const int gt = (F.vcu * NWAVES + F.wave) * 64 + F.lane;
      if (gt < 128 * 32) { const int p = gt >> 5, f = gt & 31; const float inv = powf(10000.f, -(float)(2 * f) / 64.f); const float a = (float)p * inv; float sn, cs; sincosf(a, &sn, &cs); F.TAB[gt] = (f32x2){cs, sn}; } }
    { const int gt = (F.vcu * NWAVES + F.wave) * 64 + F.lane; constexpr int N8 = DEPTH * SGU_G * CHUNK * CHUNK / 8;
      if (gt < N8) { const f32x4 a = ((const f32x4*)F.sgu_w)[2 * gt], b = ((const f32x4*)F.sgu_w)[2 * gt + 1]; v4u o; o.x = pk2(a.x, a.y); o.y = pk2(a.z, a.w); o.z = pk2(b.x, b.y); o.w = pk2(b.z, b.w); ((v4u*)F.WSB)[gt] = o; } }
    for (int m = gw; m < M; m += 4 * NGW) { const int left = (M - 1 - m) / NGW + 1; rows4_to_bf16_ssq(F.lane, F.x, F.XB, F.SSQP, m, NGW, left < 4 ? left : 4); }
}

__device__ __forceinline__ float silu_e(float v) { return v * __builtin_amdgcn_rcpf(1.f + __builtin_amdgcn_exp2f(v * -1.4426950408889634f)); }
struct EpiIn {
    static constexpr bool PERM = true, AFTER_DRAIN = false; static constexpr int MIDK = 0;
    const float* ssqp; bf16 *Q, *K, *V, *MIX, *H, *CB, *U, *VN; const float *qnw, *knw, *snw, *bw; const f32x2* tab; LAS float* P; LAS float* R; mutable int cpm;
    __device__ __forceinline__ void store8(bf16* p, const pg8::f32x4& a, const pg8::f32x4& b) const {
        pg8::u32x4 w; w.x = pg8::cvt_pk_bf16(a[0], a[1]); w.y = pg8::cvt_pk_bf16(a[2], a[3]); w.z = pg8::cvt_pk_bf16(b[0], b[1]); w.w = pg8::cvt_pk_bf16(b[2], b[3]); *(pg8::u32x4*)p = w; }
    static __device__ __forceinline__ pg8::f32x4 gelu4(const pg8::f32x4& x) { const pg8::f32x2 p = pg8::gelu_pk((pg8::f32x2){x[0], x[1]}), q = pg8::gelu_pk((pg8::f32x2){x[2], x[3]}); return (pg8::f32x4){p.x, p.y, q.x, q.y}; }
    template <bool GELU> __device__ __forceinline__ void exchange(const pg8::f32x4 (&acc)[2][2][4][2], float (&tot)[2][4][2], int wr, int wc, int fr, int fq) const {
#pragma unroll
        for (int ai = 0; ai < 2; ++ai)
#pragma unroll
            for (int m = 0; m < 4; ++m)
#pragma unroll
                for (int bj = 0; bj < 2; ++bj) { const pg8::f32x4 a = GELU ? gelu4(acc[ai][bj][m][0]) : acc[ai][bj][m][0], b = GELU ? gelu4(acc[ai][bj][m][1]) : acc[ai][bj][m][1];
                    float s = ((a[0] * a[0] + a[1] * a[1]) + (a[2] * a[2] + a[3] * a[3])) + ((b[0] * b[0] + b[1] * b[1]) + (b[2] * b[2] + b[3] * b[3]));
                    s += __shfl_xor(s, 16); s += __shfl_xor(s, 32);
                    if (fq == 0) P[((ai * 128 + wr * 64 + m * 16 + fr) * 2 + bj) * 4 + wc] = s; }
        asm volatile("s_waitcnt lgkmcnt(0)" ::: "memory"); __builtin_amdgcn_s_barrier(); asm volatile("" ::: "memory");
#pragma unroll
        for (int ai = 0; ai < 2; ++ai)
#pragma unroll
            for (int m = 0; m < 4; ++m)
#pragma unroll
                for (int bj = 0; bj < 2; ++bj) { const f32x4 q = *(const LAS f32x4*)(P + ((ai * 128 + wr * 64 + m * 16 + fr) * 2 + bj) * 4); tot[ai][m][bj] = (q.x + q.y) + (q.z + q.w); }
    }
    __device__ __forceinline__ void prep(const pg8::Unit& u, int wr, int wc, int fr, int fq) const {
        if (u.pm == cpm) return;
        asm volatile("" : "+v"(fr), "+v"(fq), "+s"(wr), "+s"(wc));
        const int t_ = (wr * 4 + wc) * 64 + fq * 16 + fr;
        if (t_ < 256) R[t_] = rstd_from_ssq8(ssqp + (size_t)(u.pm * pg8::BM + t_) * 8);
        asm volatile("s_waitcnt lgkmcnt(0)" ::: "memory"); __builtin_amdgcn_s_barrier(); asm volatile("" ::: "memory");
        cpm = u.pm;
    }
    __device__ __forceinline__ void operator()(pg8::f32x4 (&acc)[2][2][4][2], const pg8::Unit& u, int wr, int wc, int fr, int fq) const {
        asm volatile("" : "+v"(fr), "+v"(fq), "+s"(wr), "+s"(wc));
        const int pn = u.pn, row0 = u.pm * pg8::BM + wr * 64 + fr, cpos = wc * 32 + 8 * fq;
#pragma unroll
        for (int ai = 0; ai < 2; ++ai)
#pragma unroll
            for (int m = 0; m < 4; ++m) { const float rs = R[ai * 128 + wr * 64 + m * 16 + fr];
#pragma unroll
                for (int bj = 0; bj < 2; ++bj) { acc[ai][bj][m][0] *= rs; acc[ai][bj][m][1] *= rs; }
                asm volatile("" ::: "memory"); }
        const bool sgu_uv = pn >= 18 && pn < 22;
        if (sgu_uv) {
#pragma unroll
            for (int ai = 0; ai < 2; ++ai)
#pragma unroll
                for (int m = 0; m < 4; ++m)
#pragma unroll
                    for (int bj = 0; bj < 2; ++bj) { acc[ai][bj][m][0] = gelu4(acc[ai][bj][m][0]); acc[ai][bj][m][1] = gelu4(acc[ai][bj][m][1]); }
        }
        float tot[2][4][2];
        if (pn < 5 || pn == 20 || pn == 21) exchange<false>(acc, tot, wr, wc, fr, fq);
        if (pn < 5) {
            const float* wsrc = (pn < 4 ? qnw : knw) + (wc >> 1) * 64 + (wc & 1) * 16 + fq * 4;
            const f32x4 w0 = *(const f32x4*)wsrc, w1 = *(const f32x4*)(wsrc + 32);
            bf16* dst = pn < 4 ? Q + pn * 2 * HD : K; const int ld = pn < 4 ? ATTN_W : KV_W;
            const float qsc = pn < 4 ? att::SCALE * 1.4426950408889634f : 1.f;
#pragma unroll
            for (int ai = 0; ai < 2; ++ai)
#pragma unroll
                for (int m = 0; m < 4; ++m) { const int row = row0 + ai * 128 + m * 16, t = row & (SEQ - 1), p = (wc >> 1) ? (t & 63) : (t >> 6);
                    const f32x4* tp = (const f32x4*)(tab + p * 32 + (wc & 1) * 16 + fq * 4); const f32x4 t0 = tp[0], t1 = tp[1];
                    const f32x4 cs = {t0.x, t0.z, t1.x, t1.z}, sn = {t0.y, t0.w, t1.y, t1.w};
#pragma unroll
                    for (int bj = 0; bj < 2; ++bj) { const float rstd = qsc / sqrtf(tot[ai][m][bj] * (1.f / HD) + EPS);
                        const f32x4 a0 = acc[ai][bj][m][0] * rstd * w0, a1 = acc[ai][bj][m][1] * rstd * w1;
                        store8(dst + (size_t)row * ld + bj * HD + cpos, a0 * cs - a1 * sn, a1 * cs + a0 * sn); }
                    asm volatile("" ::: "memory"); }
        } else if (pn == 5 || pn == 14 || pn == 15) {
            bf16* dst = pn == 5 ? V : CB + (pn - 14) * 256; const int ld = pn == 5 ? KV_W : CONV_W;
#pragma unroll
            for (int ai = 0; ai < 2; ++ai)
#pragma unroll
                for (int m = 0; m < 4; ++m) {
#pragma unroll
                    for (int bj = 0; bj < 2; ++bj) store8(dst + (size_t)(row0 + ai * 128 + m * 16) * ld + bj * 128 + cpos, acc[ai][bj][m][0], acc[ai][bj][m][1]);
                    asm volatile("" ::: "memory"); }
        } else if (pn < 10 || pn == 16 || pn == 17 || pn >= 22) {
            const int mixc = (pn < 10 ? (pn - 6) * 256 : pn < 18 ? ATTN_W + (pn - 16) * 256 : ATTN_W + CONV_W + (pn - 22) * 256) + cpos;
            f32x4 g[2][2];
#pragma unroll
            for (int bj = 0; bj < 2; ++bj) { g[bj][0] = *(const f32x4*)(bw + mixc + bj * 128); g[bj][1] = *(const f32x4*)(bw + mixc + bj * 128 + 4); }
#pragma unroll
            for (int ai = 0; ai < 2; ++ai)
#pragma unroll
                for (int m = 0; m < 4; ++m) {
#pragma unroll
                    for (int bj = 0; bj < 2; ++bj) { pg8::f32x4 a = acc[ai][bj][m][0], b = acc[ai][bj][m][1];
#pragma unroll
                        for (int i = 0; i < 4; ++i) { a[i] = silu_e(a[i]); b[i] = silu_e(b[i]); }
                        store8(MIX + (size_t)(row0 + ai * 128 + m * 16) * LDK2 + mixc + bj * 128, a * g[bj][0], b * g[bj][1]); }
                    asm volatile("" ::: "memory"); }
        } else if (pn < 14) {
#pragma unroll
            for (int ai = 0; ai < 2; ++ai)
#pragma unroll
                for (int m = 0; m < 4; ++m) {
#pragma unroll
                    for (int bj = 0; bj < 2; ++bj) { const pg8::f32x4 h = acc[ai][bj][m][0] * acc[ai][bj][m][1];
                        v2u w; w.x = pg8::cvt_pk_bf16(h[0], h[1]); w.y = pg8::cvt_pk_bf16(h[2], h[3]);
                        *(v2u*)(H + (size_t)(row0 + ai * 128 + m * 16) * CONV_W + (pn - 10) * 128 + bj * 64 + wc * 16 + fq * 4) = w; }
                    asm volatile("" ::: "memory"); }
        } else {
            if (pn < 20) {
#pragma unroll
                for (int ai = 0; ai < 2; ++ai)
#pragma unroll
                    for (int m = 0; m < 4; ++m) {
#pragma unroll
                        for (int bj = 0; bj < 2; ++bj) store8(U + (size_t)(row0 + ai * 128 + m * 16) * SGU_W + (pn - 18) * 256 + bj * 128 + cpos, acc[ai][bj][m][0], acc[ai][bj][m][1]);
                        asm volatile("" ::: "memory"); }
            } else {
                const int c0 = (pn - 20) * 256 + cpos; f32x4 g[2][2];
#pragma unroll
                for (int bj = 0; bj < 2; ++bj) { g[bj][0] = *(const f32x4*)(snw + c0 + bj * 128); g[bj][1] = *(const f32x4*)(snw + c0 + bj * 128 + 4); }
#pragma unroll
                for (int ai = 0; ai < 2; ++ai)
#pragma unroll
                    for (int m = 0; m < 4; ++m) {
#pragma unroll
                        for (int bj = 0; bj < 2; ++bj) { const float rstd = 1.f / sqrtf(tot[ai][m][bj] * (1.f / 128.f) + EPS);
                            store8(VN + (size_t)(row0 + ai * 128 + m * 16) * SGU_W + c0 + bj * 128, acc[ai][bj][m][0] * rstd * g[bj][0], acc[ai][bj][m][1] * rstd * g[bj][1]); }
                        asm volatile("" ::: "memory"); }
            }
        }
    }
};

struct EpiOut {
    static constexpr bool PERM = true, AFTER_DRAIN = false; static constexpr int MIDK = ATTN_W / pg8::BK;
    bf16* xb; float* ssqp; LAS float* P; const float* ssqa; LAS float* R; mutable int cpm;
    __device__ __forceinline__ void prep(const pg8::Unit& u, int wr, int wc, int fr, int fq) const {
        if (u.pm == cpm) return;
        asm volatile("" : "+v"(fr), "+v"(fq), "+s"(wr), "+s"(wc));
        const int t_ = (wr * 4 + wc) * 64 + fq * 16 + fr;
        if (t_ < 256) { const float* sp = ssqa + (size_t)(u.pm * pg8::BM + t_) * 8; const f32x4 a = ((const f32x4*)sp)[0], b = ((const f32x4*)sp)[1];
            R[t_] = 1.f / sqrtf((((a.x + a.y) + (a.z + a.w)) + ((b.x + b.y) + (b.z + b.w))) * (1.f / ATTN_W) + EPS); }
        asm volatile("s_waitcnt lgkmcnt(0)" ::: "memory"); __builtin_amdgcn_s_barrier(); asm volatile("" ::: "memory");
        cpm = u.pm;
    }
    __device__ __forceinline__ void midk(pg8::f32x4 (&acc)[2][2][4][2], const pg8::Unit& u, int wr, int wc, int fr, int fq) const {
        asm volatile("" : "+v"(fr), "+v"(fq), "+s"(wr), "+s"(wc));
        const int tid_ = (wr * 4 + wc) * 64 + fq * 16 + fr;
        const bf16* pf = xb + (size_t)(u.pm * pg8::BM + (tid_ >> 1)) * LDK2 + u.pn * pg8::BM + (tid_ & 1) * 128;
        (void)*(const volatile unsigned*)pf; (void)*(const volatile unsigned*)(pf + 64);
#pragma unroll
        for (int ai = 0; ai < 2; ++ai)
#pragma unroll
            for (int m = 0; m < 4; ++m) { const float ra = R[ai * 128 + wr * 64 + m * 16 + fr];
#pragma unroll
                for (int bj = 0; bj < 2; ++bj) { acc[ai][bj][m][0] *= ra; acc[ai][bj][m][1] *= ra; } }
    }
    __device__ __forceinline__ void operator()(pg8::f32x4 (&acc)[2][2][4][2], const pg8::Unit& u, int wr, int wc, int fr, int fq) const {
        asm volatile("" : "+v"(fr), "+v"(fq), "+s"(wr), "+s"(wc));
        const int col0 = u.pn * pg8::BM + wc * 32 + 8 * fq, row0 = u.pm * pg8::BM + wr * 64 + fr;
#pragma unroll
        for (int ai = 0; ai < 2; ++ai)
#pragma unroll
            for (int m = 0; m < 4; ++m) { bf16* rp = xb + (size_t)(row0 + ai * 128 + m * 16) * LDK2 + col0; float s = 0.f;
#pragma unroll
                for (int bj = 0; bj < 2; ++bj) { const v4u q = *(const v4u*)(rp + bj * 128);
                    const pg8::f32x4 v0 = (pg8::f32x4){bflo(q.x), bfhi(q.x), bflo(q.y), bfhi(q.y)} + acc[ai][bj][m][0], v1 = (pg8::f32x4){bflo(q.z), bfhi(q.z), bflo(q.w), bfhi(q.w)} + acc[ai][bj][m][1];
                    s += ((v0[0] * v0[0] + v0[1] * v0[1]) + (v0[2] * v0[2] + v0[3] * v0[3])) + ((v1[0] * v1[0] + v1[1] * v1[1]) + (v1[2] * v1[2] + v1[3] * v1[3]));
                    v4u w; w.x = pg8::cvt_pk_bf16(v0[0], v0[1]); w.y = pg8::cvt_pk_bf16(v0[2], v0[3]); w.z = pg8::cvt_pk_bf16(v1[0], v1[1]); w.w = pg8::cvt_pk_bf16(v1[2], v1[3]); *(v4u*)(rp + bj * 128) = w; }
                s += __shfl_xor(s, 16); s += __shfl_xor(s, 32);
                if (fq == 0) P[(ai * 128 + wr * 64 + m * 16 + fr) * 4 + wc] = s; }
        asm volatile("s_waitcnt lgkmcnt(0)" ::: "memory"); __builtin_amdgcn_s_barrier(); asm volatile("" ::: "memory");
        if (wc == 0 && fq == 0) {
#pragma unroll
            for (int ai = 0; ai < 2; ++ai)
#pragma unroll
                for (int m = 0; m < 4; ++m) { const f32x4 q = *(const LAS f32x4*)(P + (ai * 128 + wr * 64 + m * 16 + fr) * 4); ssqp[(size_t)(row0 + ai * 128 + m * 16) * 8 + u.pn] = (q.x + q.y) + (q.z + q.w); }
        }
    }
};

template <bool P> struct EpiNone {
    static constexpr bool PERM = P, AFTER_DRAIN = false; static constexpr int MIDK = 0;
    __device__ __forceinline__ void prep(const pg8::Unit&, int, int, int, int) const {}
    __device__ __forceinline__ void operator()(pg8::f32x4 (&acc)[2][2][4][2], const pg8::Unit&, int, int, int, int) const {
#pragma unroll
        for (int ai = 0; ai < 2; ++ai)
#pragma unroll
            for (int bj = 0; bj < 2; ++bj)
#pragma unroll
                for (int m = 0; m < 4; ++m) asm volatile("" :: "v"(acc[ai][bj][m][0]), "v"(acc[ai][bj][m][1]));
    }
};

__device__ __forceinline__ void mix_conv_rows8(Frame& F, int l, int m0) {
    const int lane = F.lane, c = lane * 8, t0 = m0 & (SEQ - 1); const bf16* hrow = F.H + (size_t)m0 * CONV_W + c;
    const float* cw = F.conv_w + (size_t)l * CONV_W * 3 + c * 3;
    f32x4 wq[6];
#pragma unroll
    for (int j = 0; j < 6; ++j) wq[j] = *(const f32x4*)(cw + 4 * j);
    v4u hq[10], cq[8], gq[8];
    hq[0] = (t0 > 0) ? *(const v4u*)(hrow - CONV_W) : (v4u){0u, 0u, 0u, 0u};
#pragma unroll
    for (int j = 0; j < 8; ++j) hq[1 + j] = *(const v4u*)(hrow + (size_t)j * CONV_W);
    hq[9] = (t0 + 8 < SEQ) ? *(const v4u*)(hrow + (size_t)8 * CONV_W) : (v4u){0u, 0u, 0u, 0u};
    bf16* mp = F.MIX + (size_t)m0 * LDK2 + ATTN_W + c;
#pragma unroll
    for (int j = 0; j < 8; ++j) { cq[j] = *(const v4u*)(F.CB + (size_t)(m0 + j) * CONV_W + c); gq[j] = *(const v4u*)(mp + (size_t)j * LDK2); }
    float w[24];
#pragma unroll
    for (int j = 0; j < 6; ++j) { w[4 * j] = wq[j].x; w[4 * j + 1] = wq[j].y; w[4 * j + 2] = wq[j].z; w[4 * j + 3] = wq[j].w; }
#pragma unroll
    for (int j = 0; j < 8; ++j) {
        float hm[8], h0[8], hp[8], cb[8], g[8], o[8]; unpack8(hq[j], hm); unpack8(hq[j + 1], h0); unpack8(hq[j + 2], hp); unpack8(cq[j], cb); unpack8(gq[j], g);
        float s = 0.f;
#pragma unroll
        for (int k = 0; k < 8; ++k) { const float y = hm[k] * w[3 * k] + h0[k] * w[3 * k + 1] + hp[k] * w[3 * k + 2]; o[k] = cb[k] * y; s += o[k] * o[k]; }
        const float rstd = 1.f / sqrtf(wave_sum(s) * (1.f / CONV_W) + EPS);
        float r[8];
#pragma unroll
        for (int k = 0; k < 8; ++k) r[k] = o[k] * rstd * g[k];
        *(v4u*)(mp + (size_t)j * LDK2) = pack8(r); }
}
__device__ __forceinline__ void mix_sgu_unit(Frame& F, int l, int unit, char* lds_generic) {
    constexpr int VT_BYTES = 16384, OST_OFF = 2 * VT_BYTES;
    const int lane = F.lane, wave = F.wave, tid = F.tid, r32 = lane & 31, hi = lane >> 5; const size_t r0 = (size_t)(unit >> 1) * CHUNK; const int ph0 = (unit & 1) * 64;
    const int sr = tid >> 4, sc = (tid & 15) * 8, vst0 = att::v_st(sr, sc), vst1 = att::v_st(32 + sr, sc);
    const int vb0 = (int)(uintptr_t)lds_generic + att::v_rd_base(lane);
    const int wp = wave & 1, wd = wave >> 1;
    LAS float* ost = (LAS float*)(F.lds + OST_OFF + wave * 4096);
    v4u vn[4];
#pragma unroll
    for (int t = 0; t < 2; ++t) { const bf16* vp = F.VN + (r0 + 64 * t) * SGU_W + sc; vn[2 * t] = *(const v4u*)(vp + (size_t)sr * SGU_W); vn[2 * t + 1] = *(const v4u*)(vp + (size_t)(32 + sr) * SGU_W); }
#pragma unroll 1
    for (int g = 0; g < SGU_G; ++g) {
#pragma unroll
        for (int t = 0; t < 2; ++t) { *(LAS v4u*)(F.lds + t * VT_BYTES + vst0) = vn[2 * t]; *(LAS v4u*)(F.lds + t * VT_BYTES + vst1) = vn[2 * t + 1]; }
        bf16* upb = F.U + (r0 + ph0 + wp * 32 + (lane >> 3)) * SGU_W + g * 128 + wd * 32 + (lane & 7) * 4;
        v2u uu[4];
#pragma unroll
        for (int i = 0; i < 4; ++i) uu[i] = *(const v2u*)(upb + (size_t)(i * 8) * SGU_W);
        const bf16* Wrow = F.WSB + (((size_t)l * SGU_G + g) * CHUNK + ph0 + wp * 32 + r32) * CHUNK + hi * 8;
        att::bf16x8 pw[2][4];
#pragma unroll
        for (int t = 0; t < 2; ++t)
#pragma unroll
            for (int q = 0; q < 4; ++q) pw[t][q] = *(const att::bf16x8*)(Wrow + 64 * t + 16 * q);
        if (g + 1 < SGU_G) {
#pragma unroll
            for (int t = 0; t < 2; ++t) { const bf16* vp = F.VN + (r0 + 64 * t) * SGU_W + (g + 1) * 128 + sc; vn[2 * t] = *(const v4u*)(vp + (size_t)sr * SGU_W); vn[2 * t + 1] = *(const v4u*)(vp + (size_t)(32 + sr) * SGU_W); } }
        asm volatile("s_waitcnt lgkmcnt(0)" ::: "memory"); __builtin_amdgcn_s_barrier(); asm volatile("" ::: "memory");
        att::f32x16 o0 = {};
#pragma unroll
        for (int t = 0; t < 2; ++t) {
            if (wd == 0) att::pv_one<0>(o0, vb0 + t * VT_BYTES, pw[t][0], pw[t][1], pw[t][2], pw[t][3]); else if (wd == 1) att::pv_one<1>(o0, vb0 + t * VT_BYTES, pw[t][0], pw[t][1], pw[t][2], pw[t][3]);
            else if (wd == 2) att::pv_one<2>(o0, vb0 + t * VT_BYTES, pw[t][0], pw[t][1], pw[t][2], pw[t][3]); else att::pv_one<3>(o0, vb0 + t * VT_BYTES, pw[t][0], pw[t][1], pw[t][2], pw[t][3]); }
        const float* bg = F.sgu_b + ((size_t)l * SGU_G + g) * CHUNK + ph0 + wp * 32;
#pragma unroll
        for (int r = 0; r < 16; ++r) { const int pr = att::crow(r, hi); ost[pr * 32 + r32] = o0[r] + bg[pr]; }
        asm volatile("s_waitcnt lgkmcnt(0)" ::: "memory");
#pragma unroll
        for (int i = 0; i < 4; ++i) { const int pr = i * 8 + (lane >> 3), c4 = (lane & 7) * 4; const f32x4 sv = *(const LAS f32x4*)(ost + pr * 32 + c4);
            v2u w; w.x = pk2(bflo(uu[i].x) * sv.x, bfhi(uu[i].x) * sv.y); w.y = pk2(bflo(uu[i].y) * sv.z, bfhi(uu[i].y) * sv.w); *(v2u*)(upb + (size_t)(i * 8) * SGU_W) = w; }
        __syncthreads();
    }
    { const size_t mb = r0 + ph0 + wave; const int c = lane * 8;
      v4u oq[8], gq[8];
#pragma unroll
      for (int i = 0; i < 8; ++i) { oq[i] = *(const v4u*)(F.U + (mb + 8 * i) * SGU_W + c); gq[i] = *(const v4u*)(F.MIX + (mb + 8 * i) * LDK2 + ATTN_W + CONV_W + c); }
#pragma unroll
      for (int i = 0; i < 8; ++i) { float o[8], g[8]; unpack8(oq[i], o); unpack8(gq[i], g);
        float s = 0.f;
#pragma unroll
        for (int k = 0; k < 8; ++k) s += o[k] * o[k];
        const float rstd = 1.f / sqrtf(wave_sum(s) * (1.f / SGU_W) + EPS);
        float r[8];
#pragma unroll
        for (int k = 0; k < 8; ++k) r[k] = o[k] * rstd * g[k];
        *(v4u*)(F.MIX + (mb + 8 * i) * LDK2 + ATTN_W + CONV_W + c) = pack8(r); } }
}
__device__ __forceinline__ void phase_mixer(Frame& F, int l, char* lds_generic) {
    constexpr int NUNITS = BATCH * NQH * (SEQ / 256);
    const int upc = (NUNITS + F.G - 1) / F.G;
    float refB;
    { const float* qw = F.q_norm_w + l * HD; const float* kw = F.k_norm_w + l * HD; float a = fmaxf(fabsf(qw[2 * F.lane]), fabsf(qw[2 * F.lane + 1])), b = fmaxf(fabsf(kw[2 * F.lane]), fabsf(kw[2 * F.lane + 1]));
#pragma unroll
      for (int o_ = 1; o_ < 64; o_ <<= 1) { a = fmaxf(a, __shfl_xor(a, o_)); b = fmaxf(b, __shfl_xor(b, o_)); }
      refB = 128.f * att::SCALE * 1.4426950408889634f * 1.02f * a * b; refB = __builtin_bit_cast(float, __builtin_amdgcn_readfirstlane(__builtin_bit_cast(int, refB))); }
    const bool tail_first = ((F.vcu >> 2) & 1) != 0;
#pragma unroll 1
    for (int pass = 0; pass < 2; ++pass) {
      if ((pass == 0) != tail_first) {
        for (int i = 0; i < upc; ++i) {
            const int u = F.vcu * upc + i; if (u >= NUNITS) break;
            const int bkv = u >> 7, rem = u & 127, hh = rem >> 5, qb = rem & 31;
            const int b = bkv >> 1, kvh = bkv & 1, h = kvh * 4 + hh; const size_t row0 = (size_t)b * SEQ + qb * 256;
            const att::bf16* Qb = (const att::bf16*)F.Q + row0 * ATTN_W + h * HD;
            const att::bf16* Kh = (const att::bf16*)F.K + (size_t)b * SEQ * KV_W + kvh * HD; const att::bf16* Vh = (const att::bf16*)F.V + (size_t)b * SEQ * KV_W + kvh * HD;
            if (refB <= 60.f) att::attn_dense_body<att::bf16, true>(Qb, Kh, Vh, (att::bf16*)F.MIX + row0 * LDK2 + h * HD, F.SSQA + row0 * 8 + h, SEQ, lds_generic, refB);
            else att::attn_dense_body<att::bf16, false>(Qb, Kh, Vh, (att::bf16*)F.MIX + row0 * LDK2 + h * HD, F.SSQA + row0 * 8 + h, SEQ, lds_generic, 0.f);
            __syncthreads();
        }
      } else {
        F.tid = ltid(); F.lane = F.tid & 63;
        for (int u = F.vcu; u < 2 * (M / CHUNK); u += F.G) mix_sgu_unit(F, l, u, lds_generic);
        { const int gw = F.vcu * NWAVES + F.wave, NGW = F.G * NWAVES; for (int m8 = gw; m8 < M / 8; m8 += NGW) mix_conv_rows8(F, l, m8 * 8); }
        if (l == 0) { __syncthreads(); convert_weights(F, 1); }
      }
      __syncthreads();
    }
}

__device__ __forceinline__ void phase_final(Frame& F) {
    const int gw = F.vcu * NWAVES + F.wave, NGW = F.G * NWAVES, lane = F.lane;
    for (int m = gw; m < M; m += NGW) { const float rstd = rstd_from_ssq8(F.SSQP + (size_t)m * 8);
        const bf16* xr = F.XB + (size_t)m * LDK2 + lane * 8; float* orow = F.out + (size_t)m * DM + lane * 8; const float* wr = F.final_norm_w + lane * 8;
#pragma unroll
        for (int j = 0; j < 4; ++j) { float v[8]; unpack8(*(const v4u*)(xr + j * 512), v); const f32x4 w0 = *(const f32x4*)(wr + j * 512), w1 = *(const f32x4*)(wr + j * 512 + 4);
            *(f32x4*)(orow + j * 512) = (f32x4){v[0], v[1], v[2], v[3]} * rstd * w0; *(f32x4*)(orow + j * 512 + 4) = (f32x4){v[4], v[5], v[6], v[7]} * rstd * w1; } }
}

struct Args { const float* in[12]; float* out; unsigned char* ws; int ph_lo, ph_hi; };
constexpr int PH_PER_LAYER = 3, N_PHASES = 2 + DEPTH * PH_PER_LAYER;
__global__ void __launch_bounds__(NWAVES * 64, 2) fwd(Args args) {
    extern __shared__ __attribute__((aligned(16))) unsigned char lds[];
    Frame F;
    F.lds = (LAS unsigned char*)lds;
    F.G = gridDim.x; { const int bx = blockIdx.x; F.vcu = (F.G % 8 == 0) ? (bx % 8) * (F.G / 8) + bx / 8 : bx; }
    unsigned char* ws = args.ws;
    const int lo = args.ph_lo, hi = args.ph_hi;
    for (int u = threadIdx.x; u < 64; u += NWAVES * 64) ((LAS unsigned*)(F.lds + MISC_OFF))[u] = 0u;
    __syncthreads();
    const XcdBarrier bar = xcd_barrier_post((unsigned*)(ws + WS_CTL) + CW_BAR, (volatile LAS unsigned*)(F.lds + MISC_OFF) + 8);
#define SEAM(k) do { if (lo <= (k) && (k) + 1 < hi) xcd_barrier(bar); } while (0)
#define IN(k) (lo <= (k) && (k) < hi)
    typedef const __attribute__((address_space(4))) Args* KArgP;
    const KArgP kap = (KArgP)__builtin_amdgcn_kernarg_segment_ptr();
#define PHASE_IDS() do { KArgP ap_ = kap; asm volatile("" : "+s"(ap_)); unsigned char* ws_ = ap_->ws; \
    F.tid = ltid(); F.lane = F.tid & 63; F.wave = __builtin_amdgcn_readfirstlane(F.tid >> 6); \
    F.x = ap_->in[0]; F.norm_w = ap_->in[1]; F.w_in = ap_->in[2]; F.q_norm_w = ap_->in[3]; F.k_norm_w = ap_->in[4]; F.conv_w = ap_->in[5]; \
    F.sgu_norm_w = ap_->in[6]; F.sgu_w = ap_->in[7]; F.sgu_b = ap_->in[8]; F.branch_norm_w = ap_->in[9]; F.w_out = ap_->in[10]; F.final_norm_w = ap_->in[11]; F.out = ap_->out; \
    F.TAB = (f32x2*)(ws_ + WS_TAB); F.WSB = (bf16*)(ws_ + WS_WSB); F.SSQP = (float*)(ws_ + WS_SSQP); F.Win_t = (bf16*)(ws_ + WS_WIN); F.Wout_t = (bf16*)(ws_ + WS_WOUT); F.XB = (bf16*)(ws_ + WS_XB); \
    F.Q = (bf16*)(ws_ + WS_Q); F.K = (bf16*)(ws_ + WS_K); F.V = (bf16*)(ws_ + WS_V); F.MIX = (bf16*)(ws_ + WS_MIX); F.H = (bf16*)(ws_ + WS_H); F.CB = (bf16*)(ws_ + WS_CB); F.U = (bf16*)(ws_ + WS_U); \
    F.VN = (bf16*)(ws_ + WS_VN); F.SSQA = (float*)(ws_ + WS_SSQA); } while (0)
#ifndef SK0
    if (IN(0)) { PHASE_IDS(); phase_prologue(F); }
#endif
    SEAM(0);
#pragma unroll 1
    for (int l = 0; l < DEPTH; ++l) {
        const int pb = 1 + l * PH_PER_LAYER;
#ifndef SK1
        if (IN(pb + 0)) { PHASE_IDS();
            pg8::Gemm g{F.XB, F.Win_t + (size_t)l * IN_W * LDK2, M, IN_W, DM, LDK2}; pg8::StaticOrder S; S.init(M, IN_W, F.G, (int)blockIdx.x);
            EpiIn E{F.SSQP, F.Q, F.K, F.V, F.MIX, F.H, F.CB, F.U, F.VN, F.q_norm_w + l * HD, F.k_norm_w + l * HD, F.sgu_norm_w + l * SGU_W, F.branch_norm_w + l * MIX_W, F.TAB, (LAS float*)(F.lds + XCH_OFF), (LAS float*)(F.lds + MISC_OFF + 2048), -1};
            pg8::gemm_phase<EpiIn, pg8::StaticOrder, true, true>(F.lds, g, S, E);
        }
#endif
        SEAM(pb + 0);
#ifndef SK2
        if (IN(pb + 1)) { PHASE_IDS(); phase_mixer(F, l, (char*)lds); }
#endif
        SEAM(pb + 1);
#ifndef SK4
        if (IN(pb + 2)) { PHASE_IDS();
            pg8::Gemm g{F.MIX, F.Wout_t + (size_t)l * DM * LDK2, M, DM, MIX_W, LDK2}; pg8::StaticOrder S; S.init(M, DM, F.G, (int)blockIdx.x);
            EpiOut E{F.XB, F.SSQP, (LAS float*)(F.lds + XCH_OFF), F.SSQA, (LAS float*)(F.lds + MISC_OFF + 2048), -1};
            pg8::gemm_phase<EpiOut, pg8::StaticOrder, true, true>(F.lds, g, S, E);
        }
#endif
        SEAM(pb + 2);
    }
#ifndef SK5
    if (IN(N_PHASES - 1)) { PHASE_IDS(); phase_final(F); }
#endif
#undef IN
}

extern "C" void kernel_launch(void* const* d_in, const int* in_sizes, int n_in, void* d_out, int out_size, void* d_ws, size_t ws_size, hipStream_t stream) {
    static int grid = 0;
    if (grid == 0) {
        if (n_in != 12 || in_sizes[0] != M * DM || out_size != M * DM || ws_size < WS_END) { fprintf(stderr, "kernel_launch: shape mismatch (n_in %d, in0 %d, out %d, ws %zu; need ws >= %zu)\n", n_in, n_in > 0 ? in_sizes[0] : -1, out_size, ws_size, (size_t)WS_END); grid = -1; return; }
        int dev = 0, cus = 0;
        if (hipGetDevice(&dev) != hipSuccess || hipDeviceGetAttribute(&cus, hipDeviceAttributeMultiprocessorCount, dev) != hipSuccess) { grid = -1; return; }
        if (hipFuncSetAttribute((const void*)fwd, hipFuncAttributeMaxDynamicSharedMemorySize, LDS_BYTES) != hipSuccess) { fprintf(stderr, "kernel_launch: hipFuncSetAttribute failed\n"); grid = -1; return; }
        int per_cu = 0;
        if (hipOccupancyMaxActiveBlocksPerMultiprocessor(&per_cu, (const void*)fwd, NWAVES * 64, LDS_BYTES) != hipSuccess || per_cu < 1) { fprintf(stderr, "kernel_launch: occupancy query says %d blocks per CU\n", per_cu); (void)hipGetLastError(); }
        grid = cus;
    }
    if (grid < 0) return;
    Args a{};
    for (int i = 0; i < 12; ++i) a.in[i] = (const float*)d_in[i];
    a.out = (float*)d_out; a.ws = (unsigned char*)d_ws;
    a.ph_lo = 0; a.ph_hi = N_PHASES;
    if (hipMemsetAsync((char*)d_ws + WS_CTL, 0, CTL_ZERO_BYTES, stream) != hipSuccess) { fprintf(stderr, "kernel_launch: hipMemsetAsync failed\n"); return; }
    hipLaunchKernelGGL(fwd, dim3(grid), dim3(NWAVES * 64), LDS_BYTES, stream, a);
}
```

```cpp
#include <hip/hip_runtime.h>
#include <hip/hip_bf16.h>
#include <cstdio>
#include <cstdint>
#include <cmath>
constexpr int BATCH = 2, SEQ = 8192, DM = 2048, DEPTH = 2, M = BATCH * SEQ;
constexpr int HD = 128, NQH = 8, NKVH = 2, ATTN_W = 1024, KV_W = 256, CONV_W = 512, SGU_W = 512, SGU_G = 4, CHUNK = 128, IN_W = 6144, MIX_W = 2048;
constexpr int C_Q = 0, C_K = 1024, C_V = 1280, C_GA = 1536, C_CIN = 2560, C_CB = 3072, C_CC = 3584, C_GC = 4096, C_SU = 4608, C_SV = 5120, C_GS = 5632;
constexpr float EPS = 1e-6f;
constexpr int NWAVES = 8, LDS_BYTES = 147456;
constexpr int RING_BYTES = 131072, XCH_OFF = RING_BYTES, MISC_OFF = RING_BYTES + 8192;
constexpr int CW_BAR = 4096; constexpr size_t CTL_ZERO_BYTES = 65536;
constexpr size_t MiB = 1u << 20;
#ifndef PADK
#define PADK 0
#endif
constexpr int LDK2 = DM + PADK;
constexpr size_t WS_CTL = 0, WS_TAB = 1 * MiB, WS_WSB = 1 * MiB + 64 * 1024, WS_SSQP = 1 * MiB + 512 * 1024, WS_WIN = 2 * MiB, WS_WOUT = 52 * MiB, WS_XB = 70 * MiB, WS_Q = 136 * MiB, WS_K = 168 * MiB, WS_V = 176 * MiB,
                 WS_MIX = 184 * MiB, WS_H = 250 * MiB, WS_CB = 266 * MiB, WS_U = 282 * MiB, WS_VN = 298 * MiB, WS_SSQA = 314 * MiB, WS_END = 315 * MiB;
static_assert(WS_WIN + (size_t)DEPTH * IN_W * LDK2 * 2 <= WS_WOUT && WS_WOUT + (size_t)DEPTH * DM * LDK2 * 2 <= WS_XB && WS_XB + (size_t)M * LDK2 * 2 <= WS_Q && WS_Q + (size_t)M * ATTN_W * 2 <= WS_K && WS_K + (size_t)M * KV_W * 2 <= WS_V
              && WS_V + (size_t)M * KV_W * 2 <= WS_MIX && WS_MIX + (size_t)M * LDK2 * 2 <= WS_H && WS_H + (size_t)M * CONV_W * 2 <= WS_CB && WS_CB + (size_t)M * CONV_W * 2 <= WS_U && WS_U + (size_t)M * SGU_W * 2 <= WS_VN
              && WS_VN + (size_t)M * SGU_W * 2 <= WS_SSQA && WS_SSQA + (size_t)M * 8 * 4 <= WS_END && WS_SSQP + (size_t)M * 8 * 4 <= WS_WIN && WS_TAB + 128 * 32 * 8 <= WS_WSB && WS_WSB + (size_t)DEPTH * SGU_G * CHUNK * CHUNK * 2 <= WS_SSQP, "d_ws map");
#define ATT_LDQ 1024
#define ATT_LDK 256
#define ATT_LDO 1024
#define ATT_LDG LDK2
__device__ __forceinline__ int ltid() { int t = threadIdx.x; asm volatile("" : "+v"(t)); return t; }
namespace pg8 {
#define PG8_LAS __attribute__((address_space(3)))
typedef unsigned short bf16_t;
typedef short bf16x8 __attribute__((ext_vector_type(8)));
typedef float f32x4 __attribute__((ext_vector_type(4)));
typedef unsigned u32x4 __attribute__((ext_vector_type(4)));
constexpr int BM = 256, BK = 64, HALF = 128, HTB = HALF * BK * 2  , STAGE_BYTES = 8 * HTB, NXCD = 8, WGM = 8;

__host__ __device__ __forceinline__ int lds_byte(int r, int c) { const int st = (r >> 4) * 2 + (c >> 5), rr = r & 15, cc = c & 31, ob = rr * 64 + cc * 2; return st * 1024 + (ob ^ (((ob >> 9) & 1) << 5)); }
__host__ __device__ __forceinline__ void stage_rc(int b, int& R, int& C) { const int st = b / 1024, sb = b % 1024, swz = sb ^ (((sb >> 9) & 1) << 5); R = (st >> 1) * 16 + swz / 64; C = (st & 1) * 32 + (swz % 64) / 2; }
__host__ __device__ __forceinline__ int perm32(int rho) { const int n = rho >> 4, i = rho & 15; return 8 * (i >> 2) + 4 * n + (i & 3); }

struct Unit { int pm, pn; };
struct Gemm { const bf16_t* A; const bf16_t* Bt; int M, N, K, ld; };

struct StaticOrder {
    int nM, nN, nwg, G, c;
    __host__ __device__ void init(int M, int N, int G_, int c_) { nM = M / BM; nN = N / BM; nwg = nM * nN; G = G_; c = c_; }
    __host__ __device__ bool next(int i, Unit& u) const {
        const long L = (long)i * G + c; if (L >= nwg) return false;
        int wgid = (int)L; { const int q = nwg / NXCD, r = nwg % NXCD, xcd = wgid % NXCD, off = wgid / NXCD; wgid = (xcd < r ? xcd * (q + 1) : r * (q + 1) + (xcd - r) * q) + off; }
        const int nig = WGM * nN, gid = wgid / nig, fm = gid * WGM, gsz = (nM - fm) < WGM ? (nM - fm) : WGM;
        u.pm = fm + ((wgid % nig) % gsz); u.pn = (wgid % nig) / gsz; return true;
    }
    __device__ __forceinline__ void a_ready(const Unit&) const {}
    __device__ __forceinline__ void done(const Unit&) const {}
};

__device__ __forceinline__ unsigned cvt_pk_bf16(float lo, float hi) { unsigned r; asm volatile("v_cvt_pk_bf16_f32 %0, %1, %2" : "=v"(r) : "v"(lo), "v"(hi)); return r; }
typedef float f32x2 __attribute__((ext_vector_type(2)));
__device__ __forceinline__ f32x2 gelu_pk(f32x2 v) {
    const f32x2 av = __builtin_elementwise_abs(v), d = av * 0.2316418882f + 1.0f;
    f32x2 t; t.x = __builtin_amdgcn_rcpf(d.x); t.y = __builtin_amdgcn_rcpf(d.y);
    f32x2 q = t * 0.5307027145f + (-0.7265760135f); q = q * t + 0.7107068705f; q = q * t + (-0.142248368f); q = q * t + 0.127414796f; q = q * t;
    const f32x2 s = (v * v) * (-0.72134752044f);
    f32x2 e; e.x = __builtin_amdgcn_exp2f(s.x); e.y = __builtin_amdgcn_exp2f(s.y);
    const f32x2 m = v * (q * e), r = v - m;
    f32x2 o; o.x = v.x < 0.f ? m.x : r.x; o.y = v.y < 0.f ? m.y : r.y; return o;
}

template <int ACT  > struct EpiBf16 {
    static constexpr bool PERM = true, AFTER_DRAIN = false; static_assert(ACT == 0 || ACT == 1, "EpiBf16: ACT is 0 (none) or 1 (gelu_pk)");
    bf16_t* O; int ldc; const float* bias; int split_cols; size_t split_stride; float scale0;
    __device__ __forceinline__ void operator()(const f32x4 (&acc)[2][2][4][2], const Unit& u, int wr, int wc, int fr, int fq) const {
        const int row0 = u.pm * BM + wr * 64 + fr; int colt = u.pn * BM; bf16_t* base = O;
        float sc = 1.f; if (split_cols) { const int t = colt / split_cols; base += (size_t)t * split_stride; colt -= t * split_cols; if (t == 0) sc = scale0; }
        const int col0 = colt + wc * 32 + 8 * fq, bcol0 = u.pn * BM + wc * 32 + 8 * fq;
        f32x4 bv[2][2];
#pragma unroll
        for (int bj = 0; bj < 2; ++bj)
#pragma unroll
            for (int n = 0; n < 2; ++n) bv[bj][n] = bias ? *(const f32x4*)(bias + bcol0 + bj * HALF + 4 * n) : (f32x4){0.f, 0.f, 0.f, 0.f};
#pragma unroll
        for (int ai = 0; ai < 2; ++ai)
#pragma unroll
            for (int m = 0; m < 4; ++m) { bf16_t* rowp = base + (size_t)(row0 + ai * HALF + m * 16) * ldc + col0;
#pragma unroll
                for (int bj = 0; bj < 2; ++bj) { f32x4 v0 = acc[ai][bj][m][0] + bv[bj][0], v1 = acc[ai][bj][m][1] + bv[bj][1];
                    if (ACT == 1) { f32x2 a = gelu_pk((f32x2){v0[0], v0[1]}), b = gelu_pk((f32x2){v0[2], v0[3]}), c = gelu_pk((f32x2){v1[0], v1[1]}), d = gelu_pk((f32x2){v1[2], v1[3]});
                        v0 = (f32x4){a.x, a.y, b.x, b.y}; v1 = (f32x4){c.x, c.y, d.x, d.y}; }
                    v0 = v0 * sc; v1 = v1 * sc; u32x4 w; w.x = cvt_pk_bf16(v0[0], v0[1]); w.y = cvt_pk_bf16(v0[2], v0[3]); w.z = cvt_pk_bf16(v1[0], v1[1]); w.w = cvt_pk_bf16(v1[2], v1[3]);
                    *(u32x4*)(rowp + bj * HALF) = w; } }
    }
};
template <class Epi, class Sched, bool ALIGN_EPI = false, bool SP2 = false>
__device__ __forceinline__ void gemm_phase(PG8_LAS unsigned char* lds, const Gemm g, const Sched& S, const Epi& E) {
    const int tid = ltid(), wid = __builtin_amdgcn_readfirstlane(tid >> 6), lane = tid & 63, wr = wid >> 2, wc = wid & 3, fr = lane & 15, fq = lane >> 4;
    const int K = g.K, nt = K / BK, LD = g.ld;
    unsigned voffA[2], voffB[2];
#pragma unroll
    for (int i = 0; i < 2; ++i) { int R, C; stage_rc(tid * 16 + i * 8192, R, C); const int Rb = Epi::PERM ? ((R & ~31) + perm32(R & 31)) : R;
        voffA[i] = (unsigned)(R * LD + C) * 2u; voffB[i] = (unsigned)(Rb * LD + C) * 2u; }
    const size_t kstep = (size_t)(BK * 2);
    const size_t hstep = (size_t)HALF * LD * 2;
    const size_t tstep = 2 * hstep;
    const unsigned ldsw = (unsigned)wid * 1024u;
    const int aoff = lds_byte(wr * 64 + fr, fq * 8), boff = lds_byte(wc * 32 + fr, fq * 8);
#define PG8_SA(b, h) (((b) * 2 + (h)) * HTB)
#define PG8_SB(b, h) ((4 + (b) * 2 + (h)) * HTB)
#define PG8_STAGE(bufoff, gbase, voff) do { _Pragma("unroll") for (int _i = 0; _i < 2; ++_i) \
        __builtin_amdgcn_global_load_lds((const unsigned*)((const char*)(gbase) + (voff)[_i]), (PG8_LAS unsigned*)(lds + (bufoff) + ldsw + _i * 8192), 16, 0, 0); } while (0)
#define PG8_LDA(dst, b, h) do { _Pragma("unroll") for (int m = 0; m < 4; ++m) _Pragma("unroll") for (int k = 0; k < 2; ++k) dst[m][k] = *(const PG8_LAS bf16x8*)(lds + PG8_SA(b, h) + aoff + m * 2048 + k * 1024); } while (0)
#define PG8_LDB(dst, b, h) do { _Pragma("unroll") for (int n = 0; n < 2; ++n) _Pragma("unroll") for (int k = 0; k < 2; ++k) dst[n][k] = *(const PG8_LAS bf16x8*)(lds + PG8_SB(b, h) + boff + n * 2048 + k * 1024); } while (0)
#define PG8_MMA(ai, bj, At, Bt) do { __builtin_amdgcn_s_setprio(1); _Pragma("unroll") for (int m = 0; m < 4; ++m) _Pragma("unroll") for (int n = 0; n < 2; ++n) _Pragma("unroll") for (int k = 0; k < 2; ++k) \
        acc[ai][bj][m][n] = __builtin_amdgcn_mfma_f32_16x16x32_bf16(Bt[n][k], At[m][k], acc[ai][bj][m][n], 0, 0, 0); __builtin_amdgcn_s_setprio(0); } while (0)
#define PG8_WAIT_V(n) asm volatile("s_waitcnt vmcnt(" #n ")" ::: "memory")
#define PG8_WAIT_L(n) asm volatile("s_waitcnt lgkmcnt(" #n ")" ::: "memory")
#define PG8_BAR __builtin_amdgcn_s_barrier()
#define PG8_SCHED __builtin_amdgcn_sched_barrier(0)
    Unit cur, nxt; int ui = 0;
    if (!S.next(0, cur)) return;
    f32x4 acc[2][2][4][2];
#pragma unroll
    for (int a = 0; a < 2; ++a)
#pragma unroll
        for (int b = 0; b < 2; ++b)
#pragma unroll
            for (int m = 0; m < 4; ++m)
#pragma unroll
                for (int n = 0; n < 2; ++n) acc[a][b][m][n] = (f32x4){0.f, 0.f, 0.f, 0.f};
    bf16x8 At[4][2], B0[2][2], B1[2][2];
    const char* cA = (const char*)g.A + (size_t)cur.pm * tstep; const char* cB = (const char*)g.Bt + (size_t)cur.pn * tstep;
    S.a_ready(cur);
    if constexpr (SP2) {
        PG8_STAGE(PG8_SB(0, 0), cB, voffB); PG8_STAGE(PG8_SB(0, 1), cB + hstep, voffB); PG8_STAGE(PG8_SA(0, 0), cA, voffA); PG8_STAGE(PG8_SA(0, 1), cA + hstep, voffA);
        E.prep(cur, wr, wc, fr, fq);
        if (wr == 1) PG8_BAR;
        PG8_WAIT_V(2); PG8_BAR;
        PG8_STAGE(PG8_SB(1, 0), cB + kstep, voffB); PG8_STAGE(PG8_SA(1, 0), cA + kstep, voffA); PG8_STAGE(PG8_SB(1, 1), cB + hstep + kstep, voffB);
        PG8_WAIT_V(6); PG8_BAR;
    } else {
        PG8_STAGE(PG8_SB(0, 0), cB, voffB); PG8_STAGE(PG8_SA(0, 0), cA, voffA); PG8_STAGE(PG8_SB(0, 1), cB + hstep, voffB); PG8_STAGE(PG8_SA(0, 1), cA + hstep, voffA);
        if (wr == 1) PG8_BAR;
        PG8_WAIT_V(4); PG8_BAR;
        PG8_STAGE(PG8_SB(1, 0), cB + kstep, voffB); PG8_STAGE(PG8_SA(1, 0), cA + kstep, voffA); PG8_STAGE(PG8_SB(1, 1), cB + hstep + kstep, voffB);
        PG8_WAIT_V(6); PG8_BAR;
    }
    for (;;) {
        const bool has_next = S.next(ui + 1, nxt);
        const char* nA = has_next ? (const char*)g.A + (size_t)nxt.pm * tstep : cA; const char* nB = has_next ? (const char*)g.Bt + (size_t)nxt.pn * tstep : cB;
        for (int t = 0; t < nt; t += 2) {
            if constexpr (Epi::MIDK > 0) { if (t == Epi::MIDK) E.midk(acc, cur, wr, wc, fr, fq); }
            const bool last = (t == nt - 2);
            const char* a1 = cA + (size_t)(t + 1) * kstep;
            const char* a2 = last ? nA : cA + (size_t)(t + 2) * kstep; const char* b2 = last ? nB : cB + (size_t)(t + 2) * kstep;
            const char* a3 = a2 + kstep; const char* b3 = b2 + kstep;
            if (last && has_next) S.a_ready(nxt);
            if constexpr (SP2) {
            PG8_LDB(B0, 0, 0); PG8_LDB(B1, 0, 1); PG8_SCHED; PG8_LDA(At, 0, 0); PG8_STAGE(PG8_SA(1, 1), a1 + hstep, voffA);
            PG8_WAIT_V(8); PG8_WAIT_L(0); PG8_BAR; PG8_MMA(0, 0, At, B0); PG8_MMA(0, 1, At, B1); PG8_BAR; PG8_SCHED;
            PG8_LDA(At, 0, 1); PG8_STAGE(PG8_SB(0, 0), b2, voffB); PG8_STAGE(PG8_SB(0, 1), b2 + hstep, voffB); PG8_STAGE(PG8_SA(0, 0), a2, voffA);
            PG8_WAIT_V(8); PG8_WAIT_L(0); PG8_BAR; PG8_MMA(1, 0, At, B0); PG8_MMA(1, 1, At, B1); PG8_BAR; PG8_SCHED;
            PG8_LDB(B0, 1, 0); PG8_LDB(B1, 1, 1); PG8_SCHED; PG8_LDA(At, 1, 0); PG8_STAGE(PG8_SA(0, 1), a2 + hstep, voffA);
            PG8_WAIT_V(8); PG8_WAIT_L(0); PG8_BAR; PG8_MMA(0, 0, At, B0); PG8_MMA(0, 1, At, B1); PG8_BAR; PG8_SCHED;
            PG8_LDA(At, 1, 1); PG8_STAGE(PG8_SB(1, 0), b3, voffB); PG8_STAGE(PG8_SB(1, 1), b3 + hstep, voffB); PG8_STAGE(PG8_SA(1, 0), a3, voffA);
            PG8_WAIT_V(8); PG8_WAIT_L(0); PG8_BAR; PG8_MMA(1, 0, At, B0); PG8_MMA(1, 1, At, B1); PG8_BAR; PG8_SCHED;
            } else {
            PG8_LDB(B0, 0, 0); PG8_SCHED; PG8_LDA(At, 0, 0); PG8_STAGE(PG8_SA(1, 1), a1 + hstep, voffA);
            PG8_WAIT_L(8); PG8_BAR; PG8_WAIT_L(0); PG8_MMA(0, 0, At, B0); PG8_BAR; PG8_SCHED;
            PG8_LDB(B1, 0, 1); PG8_STAGE(PG8_SB(0, 0), b2, voffB);
            PG8_BAR; PG8_WAIT_L(0); PG8_MMA(0, 1, At, B1); PG8_BAR;
            PG8_LDA(At, 0, 1); PG8_STAGE(PG8_SA(0, 0), a2, voffA);
            PG8_BAR; PG8_WAIT_L(0); PG8_MMA(1, 0, At, B0); PG8_BAR; PG8_SCHED;
            PG8_STAGE(PG8_SB(0, 1), b2 + hstep, voffB);
            PG8_WAIT_V(6); PG8_BAR; PG8_MMA(1, 1, At, B1); PG8_BAR;
            PG8_LDB(B0, 1, 0); PG8_SCHED; PG8_LDA(At, 1, 0); PG8_STAGE(PG8_SA(0, 1), a2 + hstep, voffA);
            PG8_WAIT_L(8); PG8_BAR; PG8_WAIT_L(0); PG8_MMA(0, 0, At, B0); PG8_BAR; PG8_SCHED;
            PG8_LDB(B1, 1, 1); PG8_STAGE(PG8_SB(1, 0), b3, voffB);
            PG8_BAR; PG8_WAIT_L(0); PG8_MMA(0, 1, At, B1); PG8_BAR;
            PG8_LDA(At, 1, 1); PG8_STAGE(PG8_SA(1, 0), a3, voffA);
            PG8_BAR; PG8_WAIT_L(0); PG8_MMA(1, 0, At, B0); PG8_BAR; PG8_SCHED;
            PG8_STAGE(PG8_SB(1, 1), b3 + hstep, voffB);
            PG8_WAIT_V(6); PG8_BAR; PG8_MMA(1, 1, At, B1); PG8_BAR;
            }
        }
        if constexpr (ALIGN_EPI) { if (wr == 0) PG8_BAR; }
        if constexpr (!Epi::AFTER_DRAIN) { E(acc, cur, wr, wc, fr, fq); S.done(cur); }
        if (!has_next) break;
        E.prep(nxt, wr, wc, fr, fq);
#pragma unroll
        for (int a = 0; a < 2; ++a)
#pragma unroll
            for (int b = 0; b < 2; ++b)
#pragma unroll
                for (int m = 0; m < 4; ++m)
#pragma unroll
                    for (int n = 0; n < 2; ++n) acc[a][b][m][n] = (f32x4){0.f, 0.f, 0.f, 0.f};
        cur = nxt; cA = nA; cB = nB; ++ui;
        if constexpr (ALIGN_EPI) { if (wr == 1) PG8_BAR; }
    }
    PG8_WAIT_V(0);
    if constexpr (!ALIGN_EPI) { if (wr == 0) PG8_BAR; }
    PG8_BAR;
    if constexpr (Epi::AFTER_DRAIN) { E.fused(acc, cur, wr, wc, fr, fq, lds, wid, lane); S.done(cur); }
#undef PG8_SA
#undef PG8_SB
#undef PG8_STAGE
#undef PG8_LDA
#undef PG8_LDB
#undef PG8_MMA
#undef PG8_WAIT_V
#undef PG8_WAIT_L
#undef PG8_BAR
#undef PG8_SCHED
}
}

namespace att {
using bf16 = __hip_bfloat16;
constexpr int   D = 128, NW = 8, QBLK = 32, KVBLK = 64;
constexpr float SCALE = 0.088388347648318440f;
constexpr float THR = 8.f;
constexpr int SDEPTH = 1;
constexpr int LDQ = ATT_LDQ, LDK = ATT_LDK, LDO = ATT_LDO, LDG = ATT_LDG;
constexpr size_t SHM_V = KVBLK * D * 2, SHM_K = KVBLK * D * 2, SHM_ATTN = 2 * SHM_V + 2 * SHM_K + NW * 64 * 4;
using bf16x8 = __attribute__((ext_vector_type(8))) short;
using s16x4  = __attribute__((ext_vector_type(4))) short;
using f32x16 = __attribute__((ext_vector_type(16))) float;
using f32x8  = __attribute__((ext_vector_type(8))) float;
using u32x4  = __attribute__((ext_vector_type(4))) unsigned;
#define KSWZ(row, colB) ((row) * 256 + ((colB) ^ (((row) & 7) << 4)))
#define SBAR() __builtin_amdgcn_sched_barrier(0)
__device__ __forceinline__ int crow(int r, int hi) { return (r & 3) + 8 * (r >> 2) + 4 * hi; }
__device__ __forceinline__ unsigned cvtpk(float lo, float hi) {
  unsigned r; asm volatile("v_cvt_pk_bf16_f32 %0, %1, %2" : "=v"(r) : "v"(lo), "v"(hi)); return r;
}
template <typename TIn> struct Stage;
template <> struct Stage<bf16>  { using T = bf16x8;
  __device__ static __forceinline__ T ld8(const bf16* p) { return *reinterpret_cast<const bf16x8*>(p); }
  __device__ static __forceinline__ bf16x8 tobf(T x) { return x; } };
template <> struct Stage<float> { using T = f32x8;
  __device__ static __forceinline__ T ld8(const float* p) { return *reinterpret_cast<const f32x8*>(p); }
  __device__ static __forceinline__ bf16x8 tobf(T x) {
    u32x4 w = {cvtpk(x[0], x[1]), cvtpk(x[2], x[3]), cvtpk(x[4], x[5]), cvtpk(x[6], x[7])}; return *reinterpret_cast<bf16x8*>(&w); } };

__device__ __forceinline__ void partialSM(f32x16& p0, f32x16& p1, float& m_reg, float& mn, float& alpha) {
  constexpr float C = SCALE * 1.4426950408889634f;
  float pmax = p0[0]; for (int r = 1; r < 16; ++r) pmax = fmaxf(pmax, p0[r]); for (int r = 0; r < 16; ++r) pmax = fmaxf(pmax, p1[r]);
  { auto rr = __builtin_amdgcn_permlane32_swap(__float_as_uint(pmax), __float_as_uint(pmax), false, false);
    pmax = fmaxf(__uint_as_float(rr[0]), __uint_as_float(rr[1])); }
  if (__builtin_expect(__all(pmax - m_reg <= THR / SCALE), 1)) { mn = m_reg; alpha = 1.f; }
  else { mn = fmaxf(m_reg, pmax); alpha = __builtin_amdgcn_exp2f((m_reg - mn) * C); m_reg = mn; }
  float mnC = -mn * C;
  for (int r = 0; r < 16; ++r) p0[r] = fmaf(p0[r], C, mnC); for (int r = 0; r < 16; ++r) p1[r] = fmaf(p1[r], C, mnC);
  for (int r = 0; r < 16; ++r) p0[r] = __builtin_amdgcn_exp2f(p0[r]);
}
__device__ __forceinline__ void finishSM(f32x16& p0, f32x16& p1, float alpha, float& l_reg, bf16x8& pa0, bf16x8& pa1, bf16x8& pa2, bf16x8& pa3) {
  for (int r = 0; r < 16; ++r) p1[r] = __builtin_amdgcn_exp2f(p1[r]);
  float ps = 0; for (int r = 0; r < 16; ++r) ps += p0[r]; for (int r = 0; r < 16; ++r) ps += p1[r];
  { auto rr = __builtin_amdgcn_permlane32_swap(__float_as_uint(ps), __float_as_uint(ps), false, false);
    ps = __uint_as_float(rr[0]) + __uint_as_float(rr[1]); }
  l_reg = l_reg * alpha + ps;
#define PK4(P, BASE, OUT) do { unsigned a0 = cvtpk(P[BASE + 0], P[BASE + 1]), a1 = cvtpk(P[BASE + 2], P[BASE + 3]);   \
    unsigned b0 = cvtpk(P[BASE + 4], P[BASE + 5]), b1 = cvtpk(P[BASE + 6], P[BASE + 7]);                              \
    auto r0 = __builtin_amdgcn_permlane32_swap(a0, b0, false, false); auto r1 = __builtin_amdgcn_permlane32_swap(a1, b1, false, false); \
    u32x4 w = {r0[0], r1[0], r0[1], r1[1]}; OUT = *reinterpret_cast<bf16x8*>(&w); } while (0)
  PK4(p0, 0, pa0); PK4(p0, 8, pa1); PK4(p1, 0, pa2); PK4(p1, 8, pa3);
#undef PK4
}
__device__ __forceinline__ void qkt(f32x16& p0, f32x16& p1, const bf16* Ks, const bf16x8* qr, int r32, int hi) {
  p0 = f32x16{}; p1 = f32x16{};
  for (int d0 = 0; d0 < 8; ++d0) { int cb = (d0 * 16 + hi * 8) * 2;
    bf16x8 b0 = *reinterpret_cast<const bf16x8*>((const char*)Ks + KSWZ(r32, cb));
    bf16x8 b1 = *reinterpret_cast<const bf16x8*>((const char*)Ks + KSWZ(32 + r32, cb));
    p0 = __builtin_amdgcn_mfma_f32_32x32x16_bf16(b0, qr[d0], p0, 0, 0, 0);
    p1 = __builtin_amdgcn_mfma_f32_32x32x16_bf16(b1, qr[d0], p1, 0, 0, 0); }
}
__device__ __forceinline__ int v_st(int k, int c) { const int kk = (k & ~0xC) | ((k & 4) << 1) | ((k & 8) >> 1); return ((kk >> 3) * 4 + (c >> 5)) * 512 + ((kk & 7) * 32 + (c & 31)) * 2; }
__device__ __forceinline__ int v_rd_base(int lane) { return ((lane & 3) << 3) | (((lane >> 2) & 3) << 6) | (((lane >> 4) & 1) << 5) | (((lane >> 5) & 1) << 8); }
constexpr int v_rd_off(int d0, int ks, int half) { return d0 * 512 + ks * 4096 + half * 2048; }
template <int OFF> __device__ __forceinline__ s16x4 tr_read(int vb) {
  s16x4 r; asm volatile("ds_read_b64_tr_b16 %0, %1 offset:%2" : "=&v"(r) : "v"(vb), "i"(OFF) : "memory"); return r;
}
template <int D0> __device__ __forceinline__ void pv_one(f32x16& od, int vb, bf16x8 pa0, bf16x8 pa1, bf16x8 pa2, bf16x8 pa3) {
  const s16x4 l0 = tr_read<v_rd_off(D0, 0, 0)>(vb), h0 = tr_read<v_rd_off(D0, 0, 1)>(vb), l1 = tr_read<v_rd_off(D0, 1, 0)>(vb), h1 = tr_read<v_rd_off(D0, 1, 1)>(vb);
  const s16x4 l2 = tr_read<v_rd_off(D0, 2, 0)>(vb), h2 = tr_read<v_rd_off(D0, 2, 1)>(vb), l3 = tr_read<v_rd_off(D0, 3, 0)>(vb), h3 = tr_read<v_rd_off(D0, 3, 1)>(vb);
  asm volatile("s_waitcnt lgkmcnt(0)" ::: "memory"); SBAR();
#define PK(L, H) (bf16x8){L[0], L[1], L[2], L[3], H[0], H[1], H[2], H[3]}
  od = __builtin_amdgcn_mfma_f32_32x32x16_bf16(pa0, PK(l0, h0), od, 0, 0, 0);
  od = __builtin_amdgcn_mfma_f32_32x32x16_bf16(pa1, PK(l1, h1), od, 0, 0, 0);
  od = __builtin_amdgcn_mfma_f32_32x32x16_bf16(pa2, PK(l2, h2), od, 0, 0, 0);
  od = __builtin_amdgcn_mfma_f32_32x32x16_bf16(pa3, PK(l3, h3), od, 0, 0, 0);
#undef PK
}
__device__ __forceinline__ void pv_d0(f32x16* o, int vb, bf16x8 pa0, bf16x8 pa1, bf16x8 pa2, bf16x8 pa3) {
  pv_one<0>(o[0], vb, pa0, pa1, pa2, pa3); pv_one<1>(o[1], vb, pa0, pa1, pa2, pa3); pv_one<2>(o[2], vb, pa0, pa1, pa2, pa3); pv_one<3>(o[3], vb, pa0, pa1, pa2, pa3);
}

constexpr float THRL = THR * 1.4426950408889634f;
__device__ __forceinline__ void qkt2(f32x16& p0, f32x16& p1, const bf16* Ks, const bf16x8* qr, const f32x16& negm, int r32, int hi) {
  p0 = negm; p1 = negm;
  for (int d0 = 0; d0 < 8; ++d0) { int cb = (d0 * 16 + hi * 8) * 2;
    bf16x8 b0 = *reinterpret_cast<const bf16x8*>((const char*)Ks + KSWZ(r32, cb));
    bf16x8 b1 = *reinterpret_cast<const bf16x8*>((const char*)Ks + KSWZ(32 + r32, cb));
    p0 = __builtin_amdgcn_mfma_f32_32x32x16_bf16(b0, qr[d0], p0, 0, 0, 0);
    p1 = __builtin_amdgcn_mfma_f32_32x32x16_bf16(b1, qr[d0], p1, 0, 0, 0); }
}
template <bool FIRST> __device__ __forceinline__ void partialSM2(f32x16& p0, f32x16& p1, float& m_ref, f32x16& negm, float& alpha) {
  float pmax = p0[0]; for (int r = 1; r < 16; ++r) pmax = fmaxf(pmax, p0[r]); for (int r = 0; r < 16; ++r) pmax = fmaxf(pmax, p1[r]);
  { auto rr = __builtin_amdgcn_permlane32_swap(__float_as_uint(pmax), __float_as_uint(pmax), false, false);
    pmax = fmaxf(__uint_as_float(rr[0]), __uint_as_float(rr[1])); }
  alpha = 1.f;
  if (FIRST || __builtin_expect(!__all(pmax <= THRL), 0)) {
    const float dl = FIRST ? pmax : fmaxf(pmax, 0.f);
    m_ref += dl;
    for (int r = 0; r < 16; ++r) { p0[r] -= dl; p1[r] -= dl; }
    for (int r = 0; r < 16; ++r) negm[r] = -m_ref;
    asm volatile("" : "+v"(negm));
    if (!FIRST) alpha = __builtin_amdgcn_exp2f(-dl);
  }
}

__device__ __forceinline__ void glds16s(const void* sbase, unsigned voff, unsigned lds_dst) { unsigned keep;
  asm volatile("s_nop 4\n\ts_mov_b32 %0, m0\n\ts_mov_b32 m0, %3\n\ts_nop 0\n\tglobal_load_lds_dwordx4 %1, %2\n\ts_mov_b32 m0, %0" : "=&s"(keep) : "v"(voff), "s"(sbase), "s"(lds_dst) : "memory"); }
__device__ __forceinline__ const char* uni_ptr(const void* p) { const unsigned long long v = (unsigned long long)p;
  const unsigned lo = __builtin_amdgcn_readfirstlane((unsigned)v), hi = __builtin_amdgcn_readfirstlane((unsigned)(v >> 32)); return (const char*)(((unsigned long long)hi << 32) | lo); }

#define TRD8(D0, S) S##l0 = tr_read<v_rd_off(D0, 0, 0)>(vb), S##h0 = tr_read<v_rd_off(D0, 0, 1)>(vb), S##l1 = tr_read<v_rd_off(D0, 1, 0)>(vb), S##h1 = tr_read<v_rd_off(D0, 1, 1)>(vb), \
                    S##l2 = tr_read<v_rd_off(D0, 2, 0)>(vb), S##h2 = tr_read<v_rd_off(D0, 2, 1)>(vb), S##l3 = tr_read<v_rd_off(D0, 3, 0)>(vb), S##h3 = tr_read<v_rd_off(D0, 3, 1)>(vb)
#define PKV(L, H) (bf16x8){L[0], L[1], L[2], L[3], H[0], H[1], H[2], H[3]}
#define MM4(OD, S) do { OD = __builtin_amdgcn_mfma_f32_32x32x16_bf16(pa0, PKV(S##l0, S##h0), OD, 0, 0, 0); OD = __builtin_amdgcn_mfma_f32_32x32x16_bf16(pa1, PKV(S##l1, S##h1), OD, 0, 0, 0); \
                        OD = __builtin_amdgcn_mfma_f32_32x32x16_bf16(pa2, PKV(S##l2, S##h2), OD, 0, 0, 0); OD = __builtin_amdgcn_mfma_f32_32x32x16_bf16(pa3, PKV(S##l3, S##h3), OD, 0, 0, 0); } while (0)
__device__ __forceinline__ void pv_pipe(f32x16* o, int vb, bf16x8 pa0, bf16x8 pa1, bf16x8 pa2, bf16x8 pa3) {
  s16x4 al0, ah0, al1, ah1, al2, ah2, al3, ah3, bl0, bh0, bl1, bh1, bl2, bh2, bl3, bh3;
  TRD8(0, a);
  TRD8(1, b); asm volatile("s_waitcnt lgkmcnt(8)" ::: "memory"); SBAR(); MM4(o[0], a); SBAR();
  TRD8(2, a); asm volatile("s_waitcnt lgkmcnt(8)" ::: "memory"); SBAR(); MM4(o[1], b); SBAR();
  TRD8(3, b); asm volatile("s_waitcnt lgkmcnt(8)" ::: "memory"); SBAR(); MM4(o[2], a); SBAR();
  asm volatile("s_waitcnt lgkmcnt(0)" ::: "memory"); SBAR(); MM4(o[3], b);
}
#undef TRD8
#undef PKV
#undef MM4

#define VPRE_DECL s16x4 eal0, eah0, eal1, eah1, eal2, eah2, eal3, eah3, ebl0, ebh0, ebl1, ebh1, ebl2, ebh2, ebl3, ebh3
#define VTRD8(D0, S, VB) S##l0 = tr_read<v_rd_off(D0, 0, 0)>(VB), S##h0 = tr_read<v_rd_off(D0, 0, 1)>(VB), S##l1 = tr_read<v_rd_off(D0, 1, 0)>(VB), S##h1 = tr_read<v_rd_off(D0, 1, 1)>(VB), \
                         S##l2 = tr_read<v_rd_off(D0, 2, 0)>(VB), S##h2 = tr_read<v_rd_off(D0, 2, 1)>(VB), S##l3 = tr_read<v_rd_off(D0, 3, 0)>(VB), S##h3 = tr_read<v_rd_off(D0, 3, 1)>(VB)
#define VPKV(L, H) (bf16x8){L[0], L[1], L[2], L[3], H[0], H[1], H[2], H[3]}
#define VMM4(OD, S) do { OD = __builtin_amdgcn_mfma_f32_32x32x16_bf16(pa0, VPKV(S##l0, S##h0), OD, 0, 0, 0); OD = __builtin_amdgcn_mfma_f32_32x32x16_bf16(pa1, VPKV(S##l1, S##h1), OD, 0, 0, 0); \
                         OD = __builtin_amdgcn_mfma_f32_32x32x16_bf16(pa2, VPKV(S##l2, S##h2), OD, 0, 0, 0); OD = __builtin_amdgcn_mfma_f32_32x32x16_bf16(pa3, VPKV(S##l3, S##h3), OD, 0, 0, 0); } while (0)
#define VPRE(VB) do { VTRD8(0, ea, VB); } while (0)
#define VPOST(O, VB) do { VTRD8(1, eb, VB); asm volatile("s_waitcnt lgkmcnt(8)" ::: "memory"); SBAR(); VMM4(O[0], ea); SBAR(); \
    VTRD8(2, ea, VB); asm volatile("s_waitcnt lgkmcnt(8)" ::: "memory"); SBAR(); VMM4(O[1], eb); SBAR(); \
    VTRD8(3, eb, VB); asm volatile("s_waitcnt lgkmcnt(8)" ::: "memory"); SBAR(); VMM4(O[2], ea); SBAR(); \
    asm volatile("s_waitcnt lgkmcnt(0)" ::: "memory"); SBAR(); VMM4(O[3], eb); } while (0)
__device__ __forceinline__ void finishSM2(f32x16& p0, f32x16& p1, float alpha, float& l_reg, bf16x8& pa0, bf16x8& pa1, bf16x8& pa2, bf16x8& pa3) {
  for (int r = 0; r < 16; ++r) p0[r] = __builtin_amdgcn_exp2f(p0[r]);
  for (int r = 0; r < 16; ++r) p1[r] = __builtin_amdgcn_exp2f(p1[r]);
  float ps = 0; for (int r = 0; r < 16; ++r) ps += p0[r]; for (int r = 0; r < 16; ++r) ps += p1[r];
  { auto rr = __builtin_amdgcn_permlane32_swap(__float_as_uint(ps), __float_as_uint(ps), false, false);
    ps = __uint_as_float(rr[0]) + __uint_as_float(rr[1]); }
  l_reg = l_reg * alpha + ps;
#define PK8(P, BASE, OUT) do { u32x4 w = {cvtpk(P[BASE + 0], P[BASE + 1]), cvtpk(P[BASE + 2], P[BASE + 3]), cvtpk(P[BASE + 4], P[BASE + 5]), cvtpk(P[BASE + 6], P[BASE + 7])}; OUT = *reinterpret_cast<bf16x8*>(&w); } while (0)
  PK8(p0, 0, pa0); PK8(p0, 8, pa1); PK8(p1, 0, pa2); PK8(p1, 8, pa3);
#undef PK8
}

__device__ __forceinline__ void finishFX(f32x16& p0, f32x16& p1, float& l_part, bf16x8& pa0, bf16x8& pa1, bf16x8& pa2, bf16x8& pa3) {
  for (int r = 0; r < 16; ++r) p0[r] = __builtin_amdgcn_exp2f(p0[r]);
  for (int r = 0; r < 16; ++r) p1[r] = __builtin_amdgcn_exp2f(p1[r]);
  float ps = 0; for (int r = 0; r < 16; ++r) ps += p0[r]; for (int r = 0; r < 16; ++r) ps += p1[r];
  l_part += ps;
#define PK8(P, BASE, OUT) do { u32x4 w = {cvtpk(P[BASE + 0], P[BASE + 1]), cvtpk(P[BASE + 2], P[BASE + 3]), cvtpk(P[BASE + 4], P[BASE + 5]), cvtpk(P[BASE + 6], P[BASE + 7])}; OUT = *reinterpret_cast<bf16x8*>(&w); } while (0)
  PK8(p0, 0, pa0); PK8(p0, 8, pa1); PK8(p1, 0, pa2); PK8(p1, 8, pa3);
#undef PK8
}

template <typename TQ, bool FIXED>
__device__ __forceinline__ void attn_dense_body(const TQ* __restrict__ Qb, const bf16* __restrict__ Kh_, const bf16* __restrict__ Vh_,
                                                bf16* __restrict__ Gm, float* __restrict__ ssqa, int seq, char* lds, float refB) {
  using SQ = Stage<TQ>;
  constexpr int SLOT = (int)(SHM_V + SHM_K);
  const int tid = ltid(), wid = tid >> 6, lane = tid & 63, r32 = lane & 31, hi = lane >> 5;
  const char* Kh = uni_ptr(Kh_); const char* Vh = uni_ptr(Vh_);
  float* ws = (float*)(lds + (FIXED ? 4 : 3) * SLOT) + wid * 64; float* li_l = ws; float* al_l = ws + 32;
  float m_reg = FIXED ? refB : 0.f, l_reg = 0; f32x16 negm; for (int r = 0; r < 16; ++r) negm[r] = -m_reg; asm volatile("" : "+v"(negm));
  f32x16 o[4] = {}; bf16x8 qr[8];
  const TQ* Qw = Qb + (long)(wid * QBLK + r32) * LDQ + hi * 8;
#pragma unroll
  for (int d0 = 0; d0 < 8; ++d0) qr[d0] = SQ::tobf(SQ::ld8(Qw + d0 * 16));
  const unsigned ldsb = (unsigned)(uintptr_t)lds; const int vb0 = (int)ldsb + v_rd_base(lane);
  unsigned koff[2], voff[2];
#pragma unroll
  for (int i = 0; i < 2; ++i) { const int p = 2 * wid + i, row = 4 * p + (lane >> 4), c = (lane & 15) ^ (row & 7); koff[i] = (unsigned)(row * LDK + c * 8) * 2u;
    const int l5 = lane & 31, kk = (p >> 1) * 8 + (l5 >> 2), k = kk  , cc = (2 * (p & 1) + (lane >> 5)) * 32 + (lane & 3) * 8; voff[i] = (unsigned)(k * LDK + cc) * 2u; }
#define DMA(T, off) do { const char* kb_ = Kh + (size_t)(T) * (KVBLK * LDK * 2); const char* vb_ = Vh + (size_t)(T) * (KVBLK * LDK * 2); \
    const unsigned d_ = (unsigned)__builtin_amdgcn_readfirstlane(ldsb + (unsigned)(off) + (unsigned)wid * 2048u); \
    glds16s(vb_, voff[0], d_); glds16s(vb_, voff[1], d_ + 1024u); glds16s(kb_, koff[0], d_ + (unsigned)SHM_V); glds16s(kb_, koff[1], d_ + (unsigned)SHM_V + 1024u); } while (0)
#define WAIT_BAR() asm volatile("s_waitcnt vmcnt(0) lgkmcnt(0)\n\ts_barrier" ::: "memory")
#define RESC(a) do { if (__any((a) < 1.f)) { if (hi == 0) al_l[r32] = (a); asm volatile("s_waitcnt lgkmcnt(0)" ::: "memory"); \
    for (int d = 0; d < 4; ++d) for (int r = 0; r < 16; ++r) o[d][r] *= al_l[crow(r, hi)]; } } while (0)
#define KPTR(off) ((const bf16*)(lds + (off) + SHM_V))
#define ROT() do { const int t_ = rP; rP = rK; rK = rN; rN = t_; } while (0)
#define STEP(X0, X1, XA, Y0, Y1, YA, t, WR) do { \
    if (WR) { DMA((t) + 1, rN); } \
    SBAR(); qkt2(X0, X1, KPTR(rK), qr, negm, r32, hi); \
    if constexpr (FIXED) finishFX(Y0, Y1, l_reg, pa0, pa1, pa2, pa3); else finishSM2(Y0, Y1, YA, l_reg, pa0, pa1, pa2, pa3); SBAR(); \
    pv_pipe(o, vb0 + rP, pa0, pa1, pa2, pa3); if constexpr (!FIXED) { partialSM2<false>(X0, X1, m_reg, negm, XA); RESC(XA); } \
    WAIT_BAR(); ROT(); } while (0)
  f32x16 pA0, pA1, pB0, pB1; float alA = 1.f, alB = 1.f; bf16x8 pa0, pa1, pa2, pa3; const int NT = seq / KVBLK;
  int rP = 2 * SLOT, rK = 0, rN = SLOT;
  VPRE_DECL;
  if constexpr (FIXED) {
#define SL(t_) ((((t_)) & 3) * SLOT)
#define PVD(T, VB, WR) do { const char* kb_ = Kh + (size_t)(T) * (KVBLK * LDK * 2); const char* vb_ = Vh + (size_t)(T) * (KVBLK * LDK * 2); \
    const unsigned d_ = (unsigned)__builtin_amdgcn_readfirstlane(ldsb + (unsigned)SL(T) + (unsigned)wid * 2048u); \
    VTRD8(0, ea, VB); VTRD8(1, eb, VB); asm volatile("s_waitcnt lgkmcnt(8)" ::: "memory"); SBAR(); VMM4(o[0], ea); if (WR) glds16s(vb_, voff[0], d_); SBAR(); \
    VTRD8(2, ea, VB); asm volatile("s_waitcnt lgkmcnt(8)" ::: "memory"); SBAR(); VMM4(o[1], eb); if (WR) glds16s(vb_, voff[1], d_ + 1024u); SBAR(); \
    VTRD8(3, eb, VB); asm volatile("s_waitcnt lgkmcnt(8)" ::: "memory"); SBAR(); VMM4(o[2], ea); if (WR) glds16s(kb_, koff[0], d_ + (unsigned)SHM_V); SBAR(); \
    asm volatile("s_waitcnt lgkmcnt(0)" ::: "memory"); SBAR(); VMM4(o[3], eb); if (WR) glds16s(kb_, koff[1], d_ + (unsigned)SHM_V + 1024u); } while (0)
#define STEPF(X0, X1, Y0, Y1, t_, WR) do { \
    SBAR(); qkt2(X0, X1, KPTR(SL(t_)), qr, negm, r32, hi); finishFX(Y0, Y1, l_reg, pa0, pa1, pa2, pa3); SBAR(); \
    PVD((t_) + 2, vb0 + SL((t_) - 1), WR); \
    if (WR) asm volatile("s_waitcnt vmcnt(4) lgkmcnt(0)\n\ts_barrier" ::: "memory"); else WAIT_BAR(); } while (0)
    DMA(0, 0); DMA(1, SLOT);
    asm volatile("s_waitcnt vmcnt(4) lgkmcnt(0)\n\ts_barrier" ::: "memory");
    qkt2(pA0, pA1, KPTR(0), qr, negm, r32, hi);
    DMA(2, 2 * SLOT);
    asm volatile("s_waitcnt vmcnt(4) lgkmcnt(0)\n\ts_barrier" ::: "memory");
    int t = 1;
    for (; t + 1 <= NT - 4; t += 2) { STEPF(pB0, pB1, pA0, pA1, t, true); STEPF(pA0, pA1, pB0, pB1, t + 1, true); }
    STEPF(pB0, pB1, pA0, pA1, NT - 3, true);
    STEPF(pA0, pA1, pB0, pB1, NT - 2, false);
    STEPF(pB0, pB1, pA0, pA1, NT - 1, false);
    rP = SL(NT - 1); rK = SL(NT); rN = SL(NT + 1);
#undef STEPF
#undef PVD
#undef SL
  } else {
  DMA(0, 0); DMA(1, rN);
  asm volatile("s_waitcnt vmcnt(4) lgkmcnt(0)\n\ts_barrier" ::: "memory");
  qkt2(pA0, pA1, KPTR(rK), qr, negm, r32, hi); if constexpr (!FIXED) partialSM2<true>(pA0, pA1, m_reg, negm, alA);
  WAIT_BAR(); ROT();
  int t = 1;
  for (; t + 1 <= NT - 2; t += 2) {
    STEP(pB0, pB1, alB, pA0, pA1, alA, t, true);
    STEP(pA0, pA1, alA, pB0, pB1, alB, t + 1, true);
  }
  STEP(pB0, pB1, alB, pA0, pA1, alA, NT - 1, false);
  }
  bf16* Gw = Gm + (long)(wid * QBLK) * LDG;
  u32x4 gvv[8];
#pragma unroll
  for (int i = 0; i < 8; ++i) gvv[i] = *(const u32x4*)(Gw + (long)(i * 4 + (lane >> 4)) * LDG + (lane & 15) * 8);
  if constexpr (FIXED) { finishFX(pB0, pB1, l_reg, pa0, pa1, pa2, pa3); auto rr = __builtin_amdgcn_permlane32_swap(__float_as_uint(l_reg), __float_as_uint(l_reg), false, false); l_reg = __uint_as_float(rr[0]) + __uint_as_float(rr[1]); }
  else finishSM2(pB0, pB1, alB, l_reg, pa0, pa1, pa2, pa3);
  SBAR();
  pv_pipe(o, vb0 + rP, pa0, pa1, pa2, pa3);
  if (hi == 0) li_l[r32] = l_reg; asm volatile("s_waitcnt lgkmcnt(0)" ::: "memory");
  float rli[16];
#pragma unroll
  for (int r = 0; r < 16; ++r) rli[r] = __builtin_amdgcn_rcpf(li_l[crow(r, hi)]);
  unsigned short* stg = (unsigned short*)(lds + (wid < 4 ? rK : rN) + (wid & 3) * 8192);
#pragma unroll
  for (int r = 0; r < 16; ++r) { const int orow = crow(r, hi);
#pragma unroll
    for (int d0 = 0; d0 < 4; ++d0) { const bf16 hv = __float2bfloat16(o[d0][r] * rli[r]); stg[orow * 128 + d0 * 32 + r32] = __builtin_bit_cast(unsigned short, hv); } }
  asm volatile("s_waitcnt lgkmcnt(0)" ::: "memory");
  float* sw = ssqa + (long)(wid * QBLK) * 8;
#pragma unroll
  for (int i = 0; i < 8; ++i) { const int row = i * 4 + (lane >> 4), ch = lane & 15;
    const u32x4 ov = *(const u32x4*)(stg + row * 128 + ch * 8); u32x4* gp = (u32x4*)(Gw + (long)row * LDG + ch * 8); const u32x4 gv = gvv[i];
    float s = 0.f; u32x4 w;
#pragma unroll
    for (int k = 0; k < 4; ++k) { const float o0 = __uint_as_float(ov[k] << 16), o1 = __uint_as_float(ov[k] & 0xffff0000u), g0 = __uint_as_float(gv[k] << 16), g1 = __uint_as_float(gv[k] & 0xffff0000u);
      s += o0 * o0 + o1 * o1; w[k] = cvtpk(o0 * g0, o1 * g1); }
    *gp = w;
    s += __shfl_xor(s, 1); s += __shfl_xor(s, 2); s += __shfl_xor(s, 4); s += __shfl_xor(s, 8);
    if (ch == 0) sw[row * 8] = s; }
#undef DMA
#undef WAIT_BAR
#undef RESC
#undef KPTR
#undef ROT
#undef STEP
}

#undef KSWZ
#undef SBAR
}

#define GAS __attribute__((address_space(1)))
#define LAS __attribute__((address_space(3)))
typedef unsigned short bf16;
typedef unsigned v4u __attribute__((ext_vector_type(4)));
typedef unsigned v2u __attribute__((ext_vector_type(2)));
typedef float f32x4 __attribute__((ext_vector_type(4)));
typedef float f32x2 __attribute__((ext_vector_type(2)));
__device__ __forceinline__ unsigned f2bf(float f) { unsigned u = __builtin_bit_cast(unsigned, f); return (u + 0x7fffu + ((u >> 16) & 1u)) >> 16; }
__device__ __forceinline__ unsigned pk2(float lo, float hi) { return f2bf(lo) | (f2bf(hi) << 16); }
__device__ __forceinline__ float bflo(unsigned u) { return __uint_as_float(u << 16); }
__device__ __forceinline__ float bfhi(unsigned u) { return __uint_as_float(u & 0xffff0000u); }
__device__ __forceinline__ float bf2f(bf16 h) { return __uint_as_float((unsigned)h << 16); }
__device__ __forceinline__ float wave_sum(float v) {
#pragma unroll
    for (int o = 1; o < 64; o <<= 1) v += __shfl_xor(v, o);
    return v;
}
__device__ __forceinline__ float silu_f(float g) { return g * __builtin_amdgcn_rcpf(1.f + __expf(-g)); }
__device__ __forceinline__ float gelu_f(float v) { return 0.5f * v * (1.f + erff(v * 0.70710678118654752f)); }
__device__ __forceinline__ void unpack8(const v4u& p, float (&f)[8]) {
    f[0] = bflo(p.x); f[1] = bfhi(p.x); f[2] = bflo(p.y); f[3] = bfhi(p.y); f[4] = bflo(p.z); f[5] = bfhi(p.z); f[6] = bflo(p.w); f[7] = bfhi(p.w);
}
__device__ __forceinline__ v4u pack8(const float (&f)[8]) { v4u o; o.x = pk2(f[0], f[1]); o.y = pk2(f[2], f[3]); o.z = pk2(f[4], f[5]); o.w = pk2(f[6], f[7]); return o; }

#define RLX_AGENT __ATOMIC_RELAXED, __HIP_MEMORY_SCOPE_AGENT
#define XB_TMO      128
#define XB_XCNT(j)  (256  + 64 * (j))
#define XB_XSUB(j)  (1280 + 64 * (j))
#define XB_XGEN(j)  (2304 + 64 * (j))
#define XB_TOP      3328
#define XB_TOPGEN   3392
#define XCD_BAR_WORDS 3456
#define XB_SPIN_CAP (1u << 18)

__device__ __forceinline__ unsigned xb_ld(unsigned* p)              { return __hip_atomic_load(p, __ATOMIC_RELAXED, __HIP_MEMORY_SCOPE_AGENT); }
__device__ __forceinline__ unsigned xb_add(unsigned* p, unsigned v) { return __hip_atomic_fetch_add(p, v, __ATOMIC_RELAXED, __HIP_MEMORY_SCOPE_AGENT); }
__device__ __forceinline__ unsigned xb_xcc_id() { return (unsigned)__builtin_amdgcn_s_getreg((3 << 11) | 20) & 0xFu; }
#define XB_SPIN(cond, bar) do { unsigned _sp = 0; while (cond) { __builtin_amdgcn_s_sleep(1); \
    if ((++_sp & 255u) == 0u) { if (xb_ld(&(bar)[XB_TMO])) break; if (_sp > XB_SPIN_CAP) { atomicAdd(&(bar)[XB_TMO], 1u); break; } } } } while (0)

struct XcdBarrier {
    unsigned* bar; unsigned x;
    volatile LAS unsigned* st;
};

__device__ __forceinline__ XcdBarrier xcd_barrier_post(unsigned* bar, volatile LAS unsigned* st) {
    XcdBarrier b; b.bar = bar; b.x = xb_xcc_id(); b.st = st;
    if (threadIdx.x == 0) (void)xb_add(&bar[XB_XCNT(b.x)], 1u);
    return b;
}
__device__ __forceinline__ void xcd_barrier_complete(unsigned* bar, unsigned x, unsigned& nloc, unsigned& nx) {
    const unsigned G = gridDim.x * gridDim.y * gridDim.z;
    unsigned sum, cnt, mine, sp = 0u;
    for (;;) {
        sum = 0u; cnt = 0u; mine = 0u;
#pragma unroll
        for (unsigned j = 0; j < 16; ++j) { const unsigned c = xb_ld(&bar[XB_XCNT(j)]); sum += c; cnt += (c > 0u) ? 1u : 0u; mine = (j == x) ? c : mine; }
        if (sum == G) break;
        __builtin_amdgcn_s_sleep(1);
        if ((++sp & 255u) == 0u) { if (xb_ld(&bar[XB_TMO])) break; if (sp > XB_SPIN_CAP) { atomicAdd(&bar[XB_TMO], 1u); break; } }
    }
    nloc = mine > 0u ? mine : 1u; nx = cnt > 0u ? cnt : 1u;
}

__device__ __forceinline__ void xcd_barrier(const XcdBarrier& b) {
    asm volatile("s_waitcnt vmcnt(0)" ::: "memory");
    __syncthreads();
    if (threadIdx.x == 0) {
        unsigned* bar = b.bar;
        __builtin_amdgcn_s_waitcnt(0);
        unsigned nloc = b.st[0], nx = b.st[1];
        if (nloc == 0u) { xcd_barrier_complete(bar, b.x, nloc, nx); b.st[0] = nloc; b.st[1] = nx; }
        const unsigned old = xb_add(&bar[XB_XSUB(b.x)], 1u);
        const unsigned gen = old / nloc;
        if (old + 1u == (gen + 1u) * nloc) {
            __builtin_amdgcn_fence(__ATOMIC_RELEASE, "agent");
            asm volatile("s_waitcnt vmcnt(0)" ::: "memory");
            const unsigned og = xb_add(&bar[XB_TOP], 1u);
            const unsigned tg = og / nx;
            if (og + 1u == (tg + 1u) * nx) xb_add(&bar[XB_TOPGEN], 1u);
            else XB_SPIN(xb_ld(&bar[XB_TOPGEN]) == tg, bar);
            __builtin_amdgcn_fence(__ATOMIC_ACQUIRE, "agent");
            xb_add(&bar[XB_XGEN(b.x)], 1u);
            asm volatile("s_waitcnt vmcnt(0)" ::: "memory");
        } else {
            XB_SPIN(xb_ld(&bar[XB_XGEN(b.x)]) == gen, bar);
            __builtin_amdgcn_fence(__ATOMIC_ACQUIRE, "agent");
            asm volatile("s_waitcnt vmcnt(0)" ::: "memory");
        }
    }
    __syncthreads();
}

struct Frame {
    LAS unsigned char* lds;
    int tid, lane, wave;
    int vcu, G;
    const float *x, *norm_w, *w_in, *q_norm_w, *k_norm_w, *conv_w, *sgu_norm_w, *sgu_w, *sgu_b, *branch_norm_w, *w_out, *final_norm_w;
    float* out;
    bf16 *Win_t, *Wout_t, *XB, *Q, *K, *V, *MIX, *H, *CB, *U, *VN;
    float *SSQP, *SSQA;
    f32x2* TAB;
    bf16* WSB;
};

__host__ __device__ __forceinline__ int orig_col(int nn) {
    const int tile = nn >> 8, p256 = nn & 255, bj = p256 >> 7, pos = p256 & 127, wc = pos >> 5, fq = (pos >> 3) & 3, n = (pos >> 2) & 1, i = pos & 3;
    const int d = (wc >> 1) * 64 + n * 32 + (wc & 1) * 16 + fq * 4 + i;
    if (tile < 4) return C_Q + (tile * 2 + bj) * HD + d;
    if (tile == 4) return C_K + bj * HD + d;
    if (tile == 5) return C_V + p256;
    if (tile < 10) return C_GA + (tile - 6) * 256 + p256;
    if (tile < 14) return (n ? C_CC : C_CIN) + (tile - 10) * 128 + bj * 64 + wc * 16 + fq * 4 + i;
    if (tile < 16) return C_CB + (tile - 14) * 256 + p256;
    if (tile < 18) return C_GC + (tile - 16) * 256 + p256;
    if (tile < 20) return C_SU + (tile - 18) * 256 + p256;
    if (tile < 22) return C_SV + (tile - 20) * 256 + p256;
    return C_GS + (tile - 22) * 256 + p256;
}

struct WItem { const float* src; size_t n; const float* rs; bf16* dst; };
__device__ __forceinline__ WItem witem_make(const float* W, const float* rowscale, int N, bf16* WT, int item, int lane, bool in_proj) {
    const int nblk = N / 32, kb = item / nblk, nb = item % nblk, k0 = 64 * kb, n0 = 32 * nb, j4 = (lane & 7) * 4, oc = in_proj ? orig_col(n0 + j4) : n0 + j4;
    WItem w; w.src = W + (size_t)(k0 + (lane >> 3)) * N + oc; w.n = (size_t)N; w.rs = rowscale ? rowscale + k0 : nullptr; w.dst = WT + (size_t)n0 * LDK2 + k0; return w;
}
__device__ __forceinline__ WItem witem_of(Frame& F, int which, int it) {
    if (which == 0) return witem_make(F.w_in, F.norm_w, IN_W, F.Win_t, it, F.lane, true);
    constexpr int I_IN_ = (DM / 64) * (IN_W / 32), I_OUT_ = (MIX_W / 64) * (DM / 32);
    if (it < I_IN_) return witem_make(F.w_in + (size_t)DM * IN_W, F.norm_w + DM, IN_W, F.Win_t + (size_t)IN_W * LDK2, it, F.lane, true);
    const int r = it - I_IN_, l = r / I_OUT_;
    return witem_make(F.w_out + (size_t)l * MIX_W * DM, nullptr, DM, F.Wout_t + (size_t)l * DM * LDK2, r - l * I_OUT_, F.lane, false);
}
__device__ __forceinline__ void witem_request(const WItem& w, f32x4 (&v)[8]) {
#pragma unroll
    for (int i = 0; i < 8; ++i) v[i] = *(const f32x4*)(w.src + (size_t)(8 * i) * w.n);
}
__device__ __forceinline__ void witem_finish(const WItem& w, const f32x4 (&v)[8], LAS float* scr, int lane) {
    const int j4 = (lane & 7) * 4, c = lane & 7;
    float rsv[8];
    if (w.rs) { const f32x4 a = *(const f32x4*)(w.rs + 8 * c), b = *(const f32x4*)(w.rs + 8 * c + 4); rsv[0] = a.x; rsv[1] = a.y; rsv[2] = a.z; rsv[3] = a.w; rsv[4] = b.x; rsv[5] = b.y; rsv[6] = b.z; rsv[7] = b.w; }
    else {
#pragma unroll
        for (int j = 0; j < 8; ++j) rsv[j] = 1.f; }
#pragma unroll
    for (int i = 0; i < 8; ++i) { LAS float* d = scr + (8 * i + (lane >> 3)) * 33 + j4; d[0] = v[i].x; d[1] = v[i].y; d[2] = v[i].z; d[3] = v[i].w; }
    asm volatile("s_waitcnt lgkmcnt(0)" ::: "memory");
#pragma unroll
    for (int j = 0; j < 4; ++j) { const int n = (lane >> 3) + 8 * j; const LAS float* s = scr + (8 * c) * 33 + n;
        v4u o; o.x = pk2(s[0 * 33] * rsv[0], s[1 * 33] * rsv[1]); o.y = pk2(s[2 * 33] * rsv[2], s[3 * 33] * rsv[3]); o.z = pk2(s[4 * 33] * rsv[4], s[5 * 33] * rsv[5]); o.w = pk2(s[6 * 33] * rsv[6], s[7 * 33] * rsv[7]);
        *(GAS v4u*)(w.dst + (size_t)n * LDK2 + 8 * c) = o; }
    asm volatile("s_waitcnt lgkmcnt(0)" ::: "memory");
}
__device__ __forceinline__ void rows4_to_bf16_ssq(int lane, const float* x, bf16* xb, float* ssqp, int m, int ms, int nr) {
    f32x4 v[4][8];
#pragma unroll
    for (int r = 0; r < 4; ++r) if (r < nr) { const f32x4* xr = (const f32x4*)(x + (size_t)(m + r * ms) * DM) + lane;
#pragma unroll
        for (int j = 0; j < 8; ++j) v[r][j] = xr[64 * j]; }
#pragma unroll
    for (int r = 0; r < 4; ++r) if (r < nr) { float s = 0.f;
#pragma unroll
        for (int j = 0; j < 8; ++j) s += (v[r][j].x * v[r][j].x + v[r][j].y * v[r][j].y) + (v[r][j].z * v[r][j].z + v[r][j].w * v[r][j].w);
        s = wave_sum(s);
        v2u* o8 = (v2u*)(xb + (size_t)(m + r * ms) * LDK2) + lane;
#pragma unroll
        for (int j = 0; j < 8; ++j) { v2u o; o.x = pk2(v[r][j].x, v[r][j].y); o.y = pk2(v[r][j].z, v[r][j].w); o8[64 * j] = o; }
        if (lane < 2) ((f32x4*)(ssqp + (size_t)(m + r * ms) * 8))[lane] = (f32x4){lane == 0 ? s : 0.f, 0.f, 0.f, 0.f}; }
}
__device__ __forceinline__ float rstd_from_ssq8(const float* ssq8) {
    const f32x4 a = ((const f32x4*)ssq8)[0], b = ((const f32x4*)ssq8)[1];
    return 1.f / sqrtf((((a.x + a.y) + (a.z + a.w)) + ((b.x + b.y) + (b.z + b.w))) * (1.f / DM) + EPS);
}

constexpr int I_IN = (DM / 64) * (IN_W / 32), I_OUT = (MIX_W / 64) * (DM / 32);
__device__ __forceinline__ void convert_weights(Frame& F, int which) {
    LAS float* scr = (LAS float*)(F.lds + F.wave * 16384);
    const int gw = F.vcu * NWAVES + F.wave, NGW = F.G * NWAVES, NIT = which == 0 ? I_IN : I_IN + 2 * I_OUT;
    f32x4 va[8], vb[8]; WItem wa, wb;
    int it = gw;
    if (it < NIT) { wa = witem_of(F, which, it); witem_request(wa, va); }
    while (it < NIT) {
        int nx = it + NGW;
        if (nx < NIT) { wb = witem_of(F, which, nx); witem_request(wb, vb); }
        witem_finish(wa, va, scr, F.lane);
        it = nx; if (it >= NIT) break;
        nx = it + NGW;
        if (nx < NIT) { wa = witem_of(F, which, nx); witem_request(wa, va); }
        witem_finish(wb, vb, scr, F.lane);
        it = nx;
    }
}
__device__ __forceinline__ void phase_prologue(Frame& F) {
    const int gw = F.vcu * NWAVES + F.wave, NGW = F.G * NWAVES;
    convert_weights(F, 0);
    { const int gt = (F.vcu * NWAVES + F.wave) * 64 + F.lane;
      if (gt < 128 * 32) { const int p = gt >> 5, f = gt & 31; const float inv = powf(10000.f, -(float)(2 * f) / 64.f); const float a = (float)p * inv; float sn, cs; sincosf(a, &sn, &cs); F.TAB[gt] = (f32x2){cs, sn}; } }
    { const int gt = (F.vcu * NWAVES + F.wave) * 64 + F.lane; constexpr int N8 = DEPTH * SGU_G * CHUNK * CHUNK / 8;
      if (gt < N8) { const f32x4 a = ((const f32x4*)F.sgu_w)[2 * gt], b = ((const f32x4*)F.sgu_w)[2 * gt + 1]; v4u o; o.x = pk2(a.x, a.y); o.y = pk2(a.z, a.w); o.z = pk2(b.x, b.y); o.w = pk2(b.z, b.w); ((v4u*)F.WSB)[gt] = o; } }
    for (int m = gw; m < M; m += 4 * NGW) { const int left = (M - 1 - m) / NGW + 1; rows4_to_bf16_ssq(F.lane, F.x, F.XB, F.SSQP, m, NGW, left < 4 ? left : 4); }
}

__device__ __forceinline__ float silu_e(float v) { return v * __builtin_amdgcn_rcpf(1.f + __builtin_amdgcn_exp2f(v * -1.4426950408889634f)); }
struct EpiIn {
    static constexpr bool PERM = true, AFTER_DRAIN = false; static constexpr int MIDK = 0;
    const float* ssqp; bf16 *Q, *K, *V, *MIX, *H, *CB, *U, *VN; const float *qnw, *knw, *snw, *bw; const f32x2* tab; LAS float* P; LAS float* R; mutable int cpm;
    __device__ __forceinline__ void store8(bf16* p, const pg8::f32x4& a, const pg8::f32x4& b) const {
        pg8::u32x4 w; w.x = pg8::cvt_pk_bf16(a[0], a[1]); w.y = pg8::cvt_pk_bf16(a[2], a[3]); w.z = pg8::cvt_pk_bf16(b[0], b[1]); w.w = pg8::cvt_pk_bf16(b[2], b[3]); *(pg8::u32x4*)p = w; }
    static __device__ __forceinline__ pg8::f32x4 gelu4(const pg8::f32x4& x) { const pg8::f32x2 p = pg8::gelu_pk((pg8::f32x2){x[0], x[1]}), q = pg8::gelu_pk((pg8::f32x2){x[2], x[3]}); return (pg8::f32x4){p.x, p.y, q.x, q.y}; }
    template <bool GELU> __device__ __forceinline__ void exchange(const pg8::f32x4 (&acc)[2][2][4][2], float (&tot)[2][4][2], int wr, int wc, int fr, int fq) const {
#pragma unroll
        for (int ai = 0; ai < 2; ++ai)
#pragma unroll
            for (int m = 0; m < 4; ++m)
#pragma unroll
                for (int bj = 0; bj < 2; ++bj) { const pg8::f32x4 a = GELU ? gelu4(acc[ai][bj][m][0]) : acc[ai][bj][m][0], b = GELU ? gelu4(acc[ai][bj][m][1]) : acc[ai][bj][m][1];
                    float s = ((a[0] * a[0] + a[1] * a[1]) + (a[2] * a[2] + a[3] * a[3])) + ((b[0] * b[0] + b[1] * b[1]) + (b[2] * b[2] + b[3] * b[3]));
                    s += __shfl_xor(s, 16); s += __shfl_xor(s, 32);
                    if (fq == 0) P[((ai * 128 + wr * 64 + m * 16 + fr) * 2 + bj) * 4 + wc] = s; }
        asm volatile("s_waitcnt lgkmcnt(0)" ::: "memory"); __builtin_amdgcn_s_barrier(); asm volatile("" ::: "memory");
#pragma unroll
        for (int ai = 0; ai < 2; ++ai)
#pragma unroll
            for (int m = 0; m < 4; ++m)
#pragma unroll
                for (int bj = 0; bj < 2; ++bj) { const f32x4 q = *(const LAS f32x4*)(P + ((ai * 128 + wr * 64 + m * 16 + fr) * 2 + bj) * 4); tot[ai][m][bj] = (q.x + q.y) + (q.z + q.w); }
    }
    __device__ __forceinline__ void prep(const pg8::Unit& u, int wr, int wc, int fr, int fq) const {
        if (u.pm == cpm) return;
        asm volatile("" : "+v"(fr), "+v"(fq), "+s"(wr), "+s"(wc));
        const int t_ = (wr * 4 + wc) * 64 + fq * 16 + fr;
        if (t_ < 256) R[t_] = rstd_from_ssq8(ssqp + (size_t)(u.pm * pg8::BM + t_) * 8);
        asm volatile("s_waitcnt lgkmcnt(0)" ::: "memory"); __builtin_amdgcn_s_barrier(); asm volatile("" ::: "memory");
        cpm = u.pm;
    }
    __device__ __forceinline__ void operator()(pg8::f32x4 (&acc)[2][2][4][2], const pg8::Unit& u, int wr, int wc, int fr, int fq) const {
        asm volatile("" : "+v"(fr), "+v"(fq), "+s"(wr), "+s"(wc));
        const int pn = u.pn, row0 = u.pm * pg8::BM + wr * 64 + fr, cpos = wc * 32 + 8 * fq;
#pragma unroll
        for (int ai = 0; ai < 2; ++ai)
#pragma unroll
            for (int m = 0; m < 4; ++m) { const float rs = R[ai * 128 + wr * 64 + m * 16 + fr];
#pragma unroll
                for (int bj = 0; bj < 2; ++bj) { acc[ai][bj][m][0] *= rs; acc[ai][bj][m][1] *= rs; }
                asm volatile("" ::: "memory"); }
        const bool sgu_uv = pn >= 18 && pn < 22;
        if (sgu_uv) {
#pragma unroll
            for (int ai = 0; ai < 2; ++ai)
#pragma unroll
                for (int m = 0; m < 4; ++m)
#pragma unroll
                    for (int bj = 0; bj < 2; ++bj) { acc[ai][bj][m][0] = gelu4(acc[ai][bj][m][0]); acc[ai][bj][m][1] = gelu4(acc[ai][bj][m][1]); }
        }
        float tot[2][4][2];
        if (pn < 5 || pn == 20 || pn == 21) exchange<false>(acc, tot, wr, wc, fr, fq);
        if (pn < 5) {
            const float* wsrc = (pn < 4 ? qnw : knw) + (wc >> 1) * 64 + (wc & 1) * 16 + fq * 4;
            const f32x4 w0 = *(const f32x4*)wsrc, w1 = *(const f32x4*)(wsrc + 32);
            bf16* dst = pn < 4 ? Q + pn * 2 * HD : K; const int ld = pn < 4 ? ATTN_W : KV_W;
            const float qsc = pn < 4 ? att::SCALE * 1.4426950408889634f : 1.f;
#pragma unroll
            for (int ai = 0; ai < 2; ++ai)
#pragma unroll
                for (int m = 0; m < 4; ++m) { const int row = row0 + ai * 128 + m * 16, t = row & (SEQ - 1), p = (wc >> 1) ? (t & 63) : (t >> 6);
                    const f32x4* tp = (const f32x4*)(tab + p * 32 + (wc & 1) * 16 + fq * 4); const f32x4 t0 = tp[0], t1 = tp[1];
                    const f32x4 cs = {t0.x, t0.z, t1.x, t1.z}, sn = {t0.y, t0.w, t1.y, t1.w};
#pragma unroll
                    for (int bj = 0; bj < 2; ++bj) { const float rstd = qsc / sqrtf(tot[ai][m][bj] * (1.f / HD) + EPS);
                        const f32x4 a0 = acc[ai][bj][m][0] * rstd * w0, a1 = acc[ai][bj][m][1] * rstd * w1;
                        store8(dst + (size_t)row * ld + bj * HD + cpos, a0 * cs - a1 * sn, a1 * cs + a0 * sn); }
                    asm volatile("" ::: "memory"); }
        } else if (pn == 5 || pn == 14 || pn == 15) {
            bf16* dst = pn == 5 ? V : CB + (pn - 14) * 256; const int ld = pn == 5 ? KV_W : CONV_W;
#pragma unroll
            for (int ai = 0; ai < 2; ++ai)
#pragma unroll
                for (int m = 0; m < 4; ++m) {
#pragma unroll
                    for (int bj = 0; bj < 2; ++bj) store8(dst + (size_t)(row0 + ai * 128 + m * 16) * ld + bj * 128 + cpos, acc[ai][bj][m][0], acc[ai][bj][m][1]);
                    asm volatile("" ::: "memory"); }
        } else if (pn < 10 || pn == 16 || pn == 17 || pn >= 22) {
            const int mixc = (pn < 10 ? (pn - 6) * 256 : pn < 18 ? ATTN_W + (pn - 16) * 256 : ATTN_W + CONV_W + (pn - 22) * 256) + cpos;
            f32x4 g[2][2];
#pragma unroll
            for (int bj = 0; bj < 2; ++bj) { g[bj][0] = *(const f32x4*)(bw + mixc + bj * 128); g[bj][1] = *(const f32x4*)(bw + mixc + bj * 128 + 4); }
#pragma unroll
            for (int ai = 0; ai < 2; ++ai)
#pragma unroll
                for (int m = 0; m < 4; ++m) {
#pragma unroll
                    for (int bj = 0; bj < 2; ++bj) { pg8::f32x4 a = acc[ai][bj][m][0], b = acc[ai][bj][m][1];
#pragma unroll
                        for (int i = 0; i < 4; ++i) { a[i] = silu_e(a[i]); b[i] = silu_e(b[i]); }
                        store8(MIX + (size_t)(row0 + ai * 128 + m * 16) * LDK2 + mixc + bj * 128, a * g[bj][0], b * g[bj][1]); }
                    asm volatile("" ::: "memory"); }
        } else if (pn < 14) {
#pragma unroll
            for (int ai = 0; ai < 2; ++ai)
#pragma unroll
                for (int m = 0; m < 4; ++m) {
#pragma unroll
                    for (int bj = 0; bj < 2; ++bj) { const pg8::f32x4 h = acc[ai][bj][m][0] * acc[ai][bj][m][1];
                        v2u w; w.x = pg8::cvt_pk_bf16(h[0], h[1]); w.y = pg8::cvt_pk_bf16(h[2], h[3]);
                        *(v2u*)(H + (size_t)(row0 + ai * 128 + m * 16) * CONV_W + (pn - 10) * 128 + bj * 64 + wc * 16 + fq * 4) = w; }
                    asm volatile("" ::: "memory"); }
        } else {
            if (pn < 20) {
#pragma unroll
                for (int ai = 0; ai < 2; ++ai)
#pragma unroll
                    for (int m = 0; m < 4; ++m) {
#pragma unroll
                        for (int bj = 0; bj < 2; ++bj) store8(U + (size_t)(row0 + ai * 128 + m * 16) * SGU_W + (pn - 18) * 256 + bj * 128 + cpos, acc[ai][bj][m][0], acc[ai][bj][m][1]);
                        asm volatile("" ::: "memory"); }
            } else {
                const int c0 = (pn - 20) * 256 + cpos; f32x4 g[2][2];
#pragma unroll
                for (int bj = 0; bj < 2; ++bj) { g[bj][0] = *(const f32x4*)(snw + c0 + bj * 128); g[bj][1] = *(const f32x4*)(snw + c0 + bj * 128 + 4); }
#pragma unroll
                for (int ai = 0; ai < 2; ++ai)
#pragma unroll
                    for (int m = 0; m < 4; ++m) {
#pragma unroll
                        for (int bj = 0; bj < 2; ++bj) { const float rstd = 1.f / sqrtf(tot[ai][m][bj] * (1.f / 128.f) + EPS);
                            store8(VN + (size_t)(row0 + ai * 128 + m * 16) * SGU_W + c0 + bj * 128, acc[ai][bj][m][0] * rstd * g[bj][0], acc[ai][bj][m][1] * rstd * g[bj][1]); }
                        asm volatile("" ::: "memory"); }
            }
        }
    }
};

struct EpiOut {
    static constexpr bool PERM = true, AFTER_DRAIN = false; static constexpr int MIDK = ATTN_W / pg8::BK;
    bf16* xb; float* ssqp; LAS float* P; const float* ssqa; LAS float* R; mutable int cpm;
    __device__ __forceinline__ void prep(const pg8::Unit& u, int wr, int wc, int fr, int fq) const {
        if (u.pm == cpm) return;
        asm volatile("" : "+v"(fr), "+v"(fq), "+s"(wr), "+s"(wc));
        const int t_ = (wr * 4 + wc) * 64 + fq * 16 + fr;
        if (t_ < 256) { const float* sp = ssqa + (size_t)(u.pm * pg8::BM + t_) * 8; const f32x4 a = ((const f32x4*)sp)[0], b = ((const f32x4*)sp)[1];
            R[t_] = 1.f / sqrtf((((a.x + a.y) + (a.z + a.w)) + ((b.x + b.y) + (b.z + b.w))) * (1.f / ATTN_W) + EPS); }
        asm volatile("s_waitcnt lgkmcnt(0)" ::: "memory"); __builtin_amdgcn_s_barrier(); asm volatile("" ::: "memory");
        cpm = u.pm;
    }
    __device__ __forceinline__ void midk(pg8::f32x4 (&acc)[2][2][4][2], const pg8::Unit& u, int wr, int wc, int fr, int fq) const {
        asm volatile("" : "+v"(fr), "+v"(fq), "+s"(wr), "+s"(wc));
        const int tid_ = (wr * 4 + wc) * 64 + fq * 16 + fr;
        const bf16* pf = xb + (size_t)(u.pm * pg8::BM + (tid_ >> 1)) * LDK2 + u.pn * pg8::BM + (tid_ & 1) * 128;
        (void)*(const volatile unsigned*)pf; (void)*(const volatile unsigned*)(pf + 64);
#pragma unroll
        for (int ai = 0; ai < 2; ++ai)
#pragma unroll
            for (int m = 0; m < 4; ++m) { const float ra = R[ai * 128 + wr * 64 + m * 16 + fr];
#pragma unroll
                for (int bj = 0; bj < 2; ++bj) { acc[ai][bj][m][0] *= ra; acc[ai][bj][m][1] *= ra; } }
    }
    __device__ __forceinline__ void operator()(pg8::f32x4 (&acc)[2][2][4][2], const pg8::Unit& u, int wr, int wc, int fr, int fq) const {
        asm volatile("" : "+v"(fr), "+v"(fq), "+s"(wr), "+s"(wc));
        const int col0 = u.pn * pg8::BM + wc * 32 + 8 * fq, row0 = u.pm * pg8::BM + wr * 64 + fr;
#pragma unroll
        for (int ai = 0; ai < 2; ++ai)
#pragma unroll
            for (int m = 0; m < 4; ++m) { bf16* rp = xb + (size_t)(row0 + ai * 128 + m * 16) * LDK2 + col0; float s = 0.f;
#pragma unroll
                for (int bj = 0; bj < 2; ++bj) { const v4u q = *(const v4u*)(rp + bj * 128);
                    const pg8::f32x4 v0 = (pg8::f32x4){bflo(q.x), bfhi(q.x), bflo(q.y), bfhi(q.y)} + acc[ai][bj][m][0], v1 = (pg8::f32x4){bflo(q.z), bfhi(q.z), bflo(q.w), bfhi(q.w)} + acc[ai][bj][m][1];
                    s += ((v0[0] * v0[0] + v0[1] * v0[1]) + (v0[2] * v0[2] + v0[3] * v0[3])) + ((v1[0] * v1[0] + v1[1] * v1[1]) + (v1[2] * v1[2] + v1[3] * v1[3]));
                    v4u w; w.x = pg8::cvt_pk_bf16(v0[0], v0[1]); w.y = pg8::cvt_pk_bf16(v0[2], v0[3]); w.z = pg8::cvt_pk_bf16(v1[0], v1[1]); w.w = pg8::cvt_pk_bf16(v1[2], v1[3]); *(v4u*)(rp + bj * 128) = w; }
                s += __shfl_xor(s, 16); s += __shfl_xor(s, 32);
                if (fq == 0) P[(ai * 128 + wr * 64 + m * 16 + fr) * 4 + wc] = s; }
        asm volatile("s_waitcnt lgkmcnt(0)" ::: "memory"); __builtin_amdgcn_s_barrier(); asm volatile("" ::: "memory");
        if (wc == 0 && fq == 0) {
#pragma unroll
            for (int ai = 0; ai < 2; ++ai)
#pragma unroll
                for (int m = 0; m < 4; ++m) { const f32x4 q = *(const LAS f32x4*)(P + (ai * 128 + wr * 64 + m * 16 + fr) * 4); ssqp[(size_t)(row0 + ai * 128 + m * 16) * 8 + u.pn] = (q.x + q.y) + (q.z + q.w); }
        }
    }
};

template <bool P> struct EpiNone {
    static constexpr bool PERM = P, AFTER_DRAIN = false; static constexpr int MIDK = 0;
    __device__ __forceinline__ void prep(const pg8::Unit&, int, int, int, int) const {}
    __device__ __forceinline__ void operator()(pg8::f32x4 (&acc)[2][2][4][2], const pg8::Unit&, int, int, int, int) const {
#pragma unroll
        for (int ai = 0; ai < 2; ++ai)
#pragma unroll
            for (int bj = 0; bj < 2; ++bj)
#pragma unroll
                for (int m = 0; m < 4; ++m) asm volatile("" :: "v"(acc[ai][bj][m][0]), "v"(acc[ai][bj][m][1]));
    }
};

__device__ __forceinline__ void mix_conv_rows8(Frame& F, int l, int m0) {
    const int lane = F.lane, c = lane * 8, t0 = m0 & (SEQ - 1); const bf16* hrow = F.H + (size_t)m0 * CONV_W + c;
    const float* cw = F.conv_w + (size_t)l * CONV_W * 3 + c * 3;
    f32x4 wq[6];
#pragma unroll
    for (int j = 0; j < 6; ++j) wq[j] = *(const f32x4*)(cw + 4 * j);
    v4u hq[10], cq[8], gq[8];
    hq[0] = (t0 > 0) ? *(const v4u*)(hrow - CONV_W) : (v4u){0u, 0u, 0u, 0u};
#pragma unroll
    for (int j = 0; j < 8; ++j) hq[1 + j] = *(const v4u*)(hrow + (size_t)j * CONV_W);
    hq[9] = (t0 + 8 < SEQ) ? *(const v4u*)(hrow + (size_t)8 * CONV_W) : (v4u){0u, 0u, 0u, 0u};
    bf16* mp = F.MIX + (size_t)m0 * LDK2 + ATTN_W + c;
#pragma unroll
    for (int j = 0; j < 8; ++j) { cq[j] = *(const v4u*)(F.CB + (size_t)(m0 + j) * CONV_W + c); gq[j] = *(const v4u*)(mp + (size_t)j * LDK2); }
    float w[24];
#pragma unroll
    for (int j = 0; j < 6; ++j) { w[4 * j] = wq[j].x; w[4 * j + 1] = wq[j].y; w[4 * j + 2] = wq[j].z; w[4 * j + 3] = wq[j].w; }
#pragma unroll
    for (int j = 0; j < 8; ++j) {
        float hm[8], h0[8], hp[8], cb[8], g[8], o[8]; unpack8(hq[j], hm); unpack8(hq[j + 1], h0); unpack8(hq[j + 2], hp); unpack8(cq[j], cb); unpack8(gq[j], g);
        float s = 0.f;
#pragma unroll
        for (int k = 0; k < 8; ++k) { const float y = hm[k] * w[3 * k] + h0[k] * w[3 * k + 1] + hp[k] * w[3 * k + 2]; o[k] = cb[k] * y; s += o[k] * o[k]; }
        const float rstd = 1.f / sqrtf(wave_sum(s) * (1.f / CONV_W) + EPS);
        float r[8];
#pragma unroll
        for (int k = 0; k < 8; ++k) r[k] = o[k] * rstd * g[k];
        *(v4u*)(mp + (size_t)j * LDK2) = pack8(r); }
}
__device__ __forceinline__ void mix_sgu_unit(Frame& F, int l, int unit, char* lds_generic) {
    constexpr int VT_BYTES = 16384, OST_OFF = 2 * VT_BYTES;
    const int lane = F.lane, wave = F.wave, tid = F.tid, r32 = lane & 31, hi = lane >> 5; const size_t r0 = (size_t)(unit >> 1) * CHUNK; const int ph0 = (unit & 1) * 64;
    const int sr = tid >> 4, sc = (tid & 15) * 8, vst0 = att::v_st(sr, sc), vst1 = att::v_st(32 + sr, sc);
    const int vb0 = (int)(uintptr_t)lds_generic + att::v_rd_base(lane);
    const int wp = wave & 1, wd = wave >> 1;
    LAS float* ost = (LAS float*)(F.lds + OST_OFF + wave * 4096);
    v4u vn[4];
#pragma unroll
    for (int t = 0; t < 2; ++t) { const bf16* vp = F.VN + (r0 + 64 * t) * SGU_W + sc; vn[2 * t] = *(const v4u*)(vp + (size_t)sr * SGU_W); vn[2 * t + 1] = *(const v4u*)(vp + (size_t)(32 + sr) * SGU_W); }
#pragma unroll 1
    for (int g = 0; g < SGU_G; ++g) {
#pragma unroll
        for (int t = 0; t < 2; ++t) { *(LAS v4u*)(F.lds + t * VT_BYTES + vst0) = vn[2 * t]; *(LAS v4u*)(F.lds + t * VT_BYTES + vst1) = vn[2 * t + 1]; }
        bf16* upb = F.U + (r0 + ph0 + wp * 32 + (lane >> 3)) * SGU_W + g * 128 + wd * 32 + (lane & 7) * 4;
        v2u uu[4];
#pragma unroll
        for (int i = 0; i < 4; ++i) uu[i] = *(const v2u*)(upb + (size_t)(i * 8) * SGU_W);
        const bf16* Wrow = F.WSB + (((size_t)l * SGU_G + g) * CHUNK + ph0 + wp * 32 + r32) * CHUNK + hi * 8;
        att::bf16x8 pw[2][4];
#pragma unroll
        for (int t = 0; t < 2; ++t)
#pragma unroll
            for (int q = 0; q < 4; ++q) pw[t][q] = *(const att::bf16x8*)(Wrow + 64 * t + 16 * q);
        if (g + 1 < SGU_G) {
#pragma unroll
            for (int t = 0; t < 2; ++t) { const bf16* vp = F.VN + (r0 + 64 * t) * SGU_W + (g + 1) * 128 + sc; vn[2 * t] = *(const v4u*)(vp + (size_t)sr * SGU_W); vn[2 * t + 1] = *(const v4u*)(vp + (size_t)(32 + sr) * SGU_W); } }
        asm volatile("s_waitcnt lgkmcnt(0)" ::: "memory"); __builtin_amdgcn_s_barrier(); asm volatile("" ::: "memory");
        att::f32x16 o0 = {};
#pragma unroll
        for (int t = 0; t < 2; ++t) {
            if (wd == 0) att::pv_one<0>(o0, vb0 + t * VT_BYTES, pw[t][0], pw[t][1], pw[t][2], pw[t][3]); else if (wd == 1) att::pv_one<1>(o0, vb0 + t * VT_BYTES, pw[t][0], pw[t][1], pw[t][2], pw[t][3]);
            else if (wd == 2) att::pv_one<2>(o0, vb0 + t * VT_BYTES, pw[t][0], pw[t][1], pw[t][2], pw[t][3]); else att::pv_one<3>(o0, vb0 + t * VT_BYTES, pw[t][0], pw[t][1], pw[t][2], pw[t][3]); }
        const float* bg = F.sgu_b + ((size_t)l * SGU_G + g) * CHUNK + ph0 + wp * 32;
#pragma unroll
        for (int r = 0; r < 16; ++r) { const int pr = att::crow(r, hi); ost[pr * 32 + r32] = o0[r] + bg[pr]; }
        asm volatile("s_waitcnt lgkmcnt(0)" ::: "memory");
#pragma unroll
        for (int i = 0; i < 4; ++i) { const int pr = i * 8 + (lane >> 3), c4 = (lane & 7) * 4; const f32x4 sv = *(const LAS f32x4*)(ost + pr * 32 + c4);
            v2u w; w.x = pk2(bflo(uu[i].x) * sv.x, bfhi(uu[i].x) * sv.y); w.y = pk2(bflo(uu[i].y) * sv.z, bfhi(uu[i].y) * sv.w); *(v2u*)(upb + (size_t)(i * 8) * SGU_W) = w; }
        __syncthreads();
    }
    { const size_t mb = r0 + ph0 + wave; const int c = lane * 8;
      v4u oq[8], gq[8];
#pragma unroll
      for (int i = 0; i < 8; ++i) { oq[i] = *(const v4u*)(F.U + (mb + 8 * i) * SGU_W + c); gq[i] = *(const v4u*)(F.MIX + (mb + 8 * i) * LDK2 + ATTN_W + CONV_W + c); }
#pragma unroll
      for (int i = 0; i < 8; ++i) { float o[8], g[8]; unpack8(oq[i], o); unpack8(gq[i], g);
        float s = 0.f;
#pragma unroll
        for (int k = 0; k < 8; ++k) s += o[k] * o[k];
        const float rstd = 1.f / sqrtf(wave_sum(s) * (1.f / SGU_W) + EPS);
        float r[8];
#pragma unroll
        for (int k = 0; k < 8; ++k) r[k] = o[k] * rstd * g[k];
        *(v4u*)(F.MIX + (mb + 8 * i) * LDK2 + ATTN_W + CONV_W + c) = pack8(r); } }
}
__device__ __forceinline__ void phase_mixer(Frame& F, int l, char* lds_generic) {
    constexpr int NUNITS = BATCH * NQH * (SEQ / 256);
    const int upc = (NUNITS + F.G - 1) / F.G;
    float refB;
    { const float* qw = F.q_norm_w + l * HD; const float* kw = F.k_norm_w + l * HD; float a = fmaxf(fabsf(qw[2 * F.lane]), fabsf(qw[2 * F.lane + 1])), b = fmaxf(fabsf(kw[2 * F.lane]), fabsf(kw[2 * F.lane + 1]));
#pragma unroll
      for (int o_ = 1; o_ < 64; o_ <<= 1) { a = fmaxf(a, __shfl_xor(a, o_)); b = fmaxf(b, __shfl_xor(b, o_)); }
      refB = 128.f * att::SCALE * 1.4426950408889634f * 1.02f * a * b; refB = __builtin_bit_cast(float, __builtin_amdgcn_readfirstlane(__builtin_bit_cast(int, refB))); }
    const int tpos = ((((F.vcu >> 1) % 3)) * upc + 1) / 2;
#pragma unroll 1
    for (int i = 0; i <= upc; ++i) {
      if (i == tpos) {
        F.tid = ltid(); F.lane = F.tid & 63;
        for (int u = F.vcu; u < 2 * (M / CHUNK); u += F.G) mix_sgu_unit(F, l, u, lds_generic);
        { const int gw = F.vcu * NWAVES + F.wave, NGW = F.G * NWAVES; for (int m8 = gw; m8 < M / 8; m8 += NGW) mix_conv_rows8(F, l, m8 * 8); }
        if (l == 0) { __syncthreads(); convert_weights(F, 1); }
        __syncthreads();
      }
      if (i < upc) {
            const int u = F.vcu * upc + i; if (u < NUNITS) {
            const int bkv = u >> 7, rem = u & 127, hh = rem >> 5, qb = rem & 31;
            const int b = bkv >> 1, kvh = bkv & 1, h = kvh * 4 + hh; const size_t row0 = (size_t)b * SEQ + qb * 256;
            const att::bf16* Qb = (const att::bf16*)F.Q + row0 * ATTN_W + h * HD;
            const att::bf16* Kh = (const att::bf16*)F.K + (size_t)b * SEQ * KV_W + kvh * HD; const att::bf16* Vh = (const att::bf16*)F.V + (size_t)b * SEQ * KV_W + kvh * HD;
            if (refB <= 60.f) att::attn_dense_body<att::bf16, true>(Qb, Kh, Vh, (att::bf16*)F.MIX + row0 * LDK2 + h * HD, F.SSQA + row0 * 8 + h, SEQ, lds_generic, refB);
            else att::attn_dense_body<att::bf16, false>(Qb, Kh, Vh, (att::bf16*)F.MIX + row0 * LDK2 + h * HD, F.SSQA + row0 * 8 + h, SEQ, lds_generic, 0.f);
            }
            __syncthreads();
      }
    }
}

__device__ __forceinline__ void phase_final(Frame& F) {
    const int gw = F.vcu * NWAVES + F.wave, NGW = F.G * NWAVES, lane = F.lane;
    for (int m = gw; m < M; m += NGW) { const float rstd = rstd_from_ssq8(F.SSQP + (size_t)m * 8);
        const bf16* xr = F.XB + (size_t)m * LDK2 + lane * 8; float* orow = F.out + (size_t)m * DM + lane * 8; const float* wr = F.final_norm_w + lane * 8;
#pragma unroll
        for (int j = 0; j < 4; ++j) { float v[8]; unpack8(*(const v4u*)(xr + j * 512), v); const f32x4 w0 = *(const f32x4*)(wr + j * 512), w1 = *(const f32x4*)(wr + j * 512 + 4);
            *(f32x4*)(orow + j * 512) = (f32x4){v[0], v[1], v[2], v[3]} * rstd * w0; *(f32x4*)(orow + j * 512 + 4) = (f32x4){v[4], v[5], v[6], v[7]} * rstd * w1; } }
}

struct Args { const float* in[12]; float* out; unsigned char* ws; int ph_lo, ph_hi; };
constexpr int PH_PER_LAYER = 3, N_PHASES = 2 + DEPTH * PH_PER_LAYER;
__global__ void __launch_bounds__(NWAVES * 64, 2) fwd(Args args) {
    extern __shared__ __attribute__((aligned(16))) unsigned char lds[];
    Frame F;
    F.lds = (LAS unsigned char*)lds;
    F.G = gridDim.x; { const int bx = blockIdx.x; F.vcu = (F.G % 8 == 0) ? (bx % 8) * (F.G / 8) + bx / 8 : bx; }
    unsigned char* ws = args.ws;
    const int lo = args.ph_lo, hi = args.ph_hi;
    for (int u = threadIdx.x; u < 64; u += NWAVES * 64) ((LAS unsigned*)(F.lds + MISC_OFF))[u] = 0u;
    __syncthreads();
    const XcdBarrier bar = xcd_barrier_post((unsigned*)(ws + WS_CTL) + CW_BAR, (volatile LAS unsigned*)(F.lds + MISC_OFF) + 8);
#define SEAM(k) do { if (lo <= (k) && (k) + 1 < hi) xcd_barrier(bar); } while (0)
#define IN(k) (lo <= (k) && (k) < hi)
    typedef const __attribute__((address_space(4))) Args* KArgP;
    const KArgP kap = (KArgP)__builtin_amdgcn_kernarg_segment_ptr();
#define PHASE_IDS() do { KArgP ap_ = kap; asm volatile("" : "+s"(ap_)); unsigned char* ws_ = ap_->ws; \
    F.tid = ltid(); F.lane = F.tid & 63; F.wave = __builtin_amdgcn_readfirstlane(F.tid >> 6); \
    F.x = ap_->in[0]; F.norm_w = ap_->in[1]; F.w_in = ap_->in[2]; F.q_norm_w = ap_->in[3]; F.k_norm_w = ap_->in[4]; F.conv_w = ap_->in[5]; \
    F.sgu_norm_w = ap_->in[6]; F.sgu_w = ap_->in[7]; F.sgu_b = ap_->in[8]; F.branch_norm_w = ap_->in[9]; F.w_out = ap_->in[10]; F.final_norm_w = ap_->in[11]; F.out = ap_->out; \
    F.TAB = (f32x2*)(ws_ + WS_TAB); F.WSB = (bf16*)(ws_ + WS_WSB); F.SSQP = (float*)(ws_ + WS_SSQP); F.Win_t = (bf16*)(ws_ + WS_WIN); F.Wout_t = (bf16*)(ws_ + WS_WOUT); F.XB = (bf16*)(ws_ + WS_XB); \
    F.Q = (bf16*)(ws_ + WS_Q); F.K = (bf16*)(ws_ + WS_K); F.V = (bf16*)(ws_ + WS_V); F.MIX = (bf16*)(ws_ + WS_MIX); F.H = (bf16*)(ws_ + WS_H); F.CB = (bf16*)(ws_ + WS_CB); F.U = (bf16*)(ws_ + WS_U); \
    F.VN = (bf16*)(ws_ + WS_VN); F.SSQA = (float*)(ws_ + WS_SSQA); } while (0)
#ifndef SK0
    if (IN(0)) { PHASE_IDS(); phase_prologue(F); }
#endif
    SEAM(0);
#pragma unroll 1
    for (int l = 0; l < DEPTH; ++l) {
        const int pb = 1 + l * PH_PER_LAYER;
#ifndef SK1
        if (IN(pb + 0)) { PHASE_IDS();
            pg8::Gemm g{F.XB, F.Win_t + (size_t)l * IN_W * LDK2, M, IN_W, DM, LDK2}; pg8::StaticOrder S; S.init(M, IN_W, F.G, (int)blockIdx.x);
            EpiIn E{F.SSQP, F.Q, F.K, F.V, F.MIX, F.H, F.CB, F.U, F.VN, F.q_norm_w + l * HD, F.k_norm_w + l * HD, F.sgu_norm_w + l * SGU_W, F.branch_norm_w + l * MIX_W, F.TAB, (LAS float*)(F.lds + XCH_OFF), (LAS float*)(F.lds + MISC_OFF + 2048), -1};
            pg8::gemm_phase<EpiIn, pg8::StaticOrder, true, true>(F.lds, g, S, E);
        }
#endif
        SEAM(pb + 0);
#ifndef SK2
        if (IN(pb + 1)) { PHASE_IDS(); phase_mixer(F, l, (char*)lds); }
#endif
        SEAM(pb + 1);
#ifndef SK4
        if (IN(pb + 2)) { PHASE_IDS();
            pg8::Gemm g{F.MIX, F.Wout_t + (size_t)l * DM * LDK2, M, DM, MIX_W, LDK2}; pg8::StaticOrder S; S.init(M, DM, F.G, (int)blockIdx.x);
            EpiOut E{F.XB, F.SSQP, (LAS float*)(F.lds + XCH_OFF), F.SSQA, (LAS float*)(F.lds + MISC_OFF + 2048), -1};
            pg8::gemm_phase<EpiOut, pg8::StaticOrder, true, true>(F.lds, g, S, E);
        }
#endif
        SEAM(pb + 2);
    }
#ifndef SK5
    if (IN(N_PHASES - 1)) { PHASE_IDS(); phase_final(F); }
#endif
#undef IN
}

extern "C" void kernel_launch(void* const* d_in, const int* in_sizes, int n_in, void* d_out, int out_size, void* d_ws, size_t ws_size, hipStream_t stream) {
    static int grid = 0;
    if (grid == 0) {
        if (n_in != 12 || in_sizes[0] != M * DM || out_size != M * DM || ws_size < WS_END) { fprintf(stderr, "kernel_launch: shape mismatch (n_in %d, in0 %d, out %d, ws %zu; need ws >= %zu)\n", n_in, n_in > 0 ? in_sizes[0] : -1, out_size, ws_size, (size_t)WS_END); grid = -1; return; }
        int dev = 0, cus = 0;
        if (hipGetDevice(&dev) != hipSuccess || hipDeviceGetAttribute(&cus, hipDeviceAttributeMultiprocessorCount, dev) != hipSuccess) { grid = -1; return; }
        if (hipFuncSetAttribute((const void*)fwd, hipFuncAttributeMaxDynamicSharedMemorySize, LDS_BYTES) != hipSuccess) { fprintf(stderr, "kernel_launch: hipFuncSetAttribute failed\n"); grid = -1; return; }
        int per_cu = 0;
        if (hipOccupancyMaxActiveBlocksPerMultiprocessor(&per_cu, (const void*)fwd, NWAVES * 64, LDS_BYTES) != hipSuccess || per_cu < 1) { fprintf(stderr, "kernel_launch: occupancy query says %d blocks per CU\n", per_cu); (void)hipGetLastError(); }
        grid = cus;
    }
    if (grid < 0) return;
    Args a{};
    for (int i = 0; i < 12; ++i) a.in[i] = (const float*)d_in[i];
    a.out = (float*)d_out; a.ws = (unsigned char*)d_ws;
    a.ph_lo = 0; a.ph_hi = N_PHASES;
    if (hipMemsetAsync((char*)d_ws + WS_CTL, 0, CTL_ZERO_BYTES, stream) != hipSuccess) { fprintf(stderr, "kernel_launch: hipMemsetAsync failed\n"); return; }
    hipLaunchKernelGGL(fwd, dim3(grid), dim3(NWAVES * 64), LDS_BYTES, stream, a);
}
```
